# Optimizing an MI355X kernel written in HIP

```python
import math
import jax, jax.numpy as jnp
from jax import lax
import numpy as np

D_MODEL = 1024
BATCH = 8
SEQ = 4096
DEPTH = 2

HEAD_DIM = 64
MIX_WIDTH = D_MODEL
A_WIDTH = MIX_WIDTH // 4
A_HEADS = A_WIDTH // HEAD_DIM
CHUNK = 128
B_WIDTH = MIX_WIDTH // 2
B_HEADS = B_WIDTH // HEAD_DIM
B_KV_HEADS = B_HEADS // 4
KV_WIDTH = B_KV_HEADS * HEAD_DIM
WINDOW = 128
BLOCK = WINDOW
N_BUCKETS = 32
MAX_DISTANCE = 128
C_WIDTH = MIX_WIDTH - A_WIDTH - B_WIDTH
CONV_WIDTH = 31
IN_WIDTH = 2 * A_WIDTH + B_WIDTH + 2 * KV_WIDTH + 2 * C_WIDTH
N_EXPERTS = 32
N_GROUPS = 4
EXPERTS_PER_GROUP = N_EXPERTS // N_GROUPS
TOP_K = 2
D_EXPERT = D_MODEL // 2
MOE_BLOCK = 128
ALPHA = (2 * DEPTH) ** 0.25
BETA = (8 * DEPTH) ** -0.25
LN_EPS = 1e-5
ADA_SCALE = 0.2
NEG_INF = -1e30

kernel_name = 'hybrid_gmlp_swa_conformer_grouped_moe_encoder'


def _layer_norm(x, g, b):
    xf = x.astype(jnp.float32)
    mu = jnp.mean(xf, axis=-1, keepdims=True)
    var = jnp.mean(jnp.square(xf - mu), axis=-1, keepdims=True)
    return ((xf - mu) * lax.rsqrt(var + LN_EPS)).astype(x.dtype) * g + b


def _t5_bucket(rel):
    nb = N_BUCKETS // 2
    max_exact = nb // 2
    ret = jnp.where(rel > 0, nb, 0)
    n = jnp.abs(rel)
    nf = jnp.maximum(n, 1).astype(jnp.float32)
    large = max_exact + (jnp.log(nf / max_exact) / math.log(MAX_DISTANCE / max_exact)
                         * (nb - max_exact)).astype(jnp.int32)
    large = jnp.minimum(large, nb - 1)
    return ret + jnp.where(n < max_exact, n, large)


def _spatial_gating(z, ln_g, ln_b, ws, bs):
    bsz, seq, _ = z.shape
    u, v = jnp.split(z, 2, axis=-1)
    v = _layer_norm(v, ln_g, ln_b).reshape(bsz, seq // CHUNK, CHUNK, A_HEADS, HEAD_DIM)
    mixed = jnp.einsum('hpq,bnqhd->bnphd', ws, v) + bs.T[None, None, :, :, None]
    return u * mixed.reshape(bsz, seq, A_WIDTH)


def _banded_gqa(q, k, v, sink, rel_bias):
    bsz, seq = q.shape[:2]
    nblk = seq // BLOCK
    grp = B_HEADS // B_KV_HEADS
    qb = q.reshape(bsz, nblk, BLOCK, B_KV_HEADS, grp, HEAD_DIM)

    def band(t):
        tp = jnp.pad(t, ((0, 0), (BLOCK, BLOCK), (0, 0), (0, 0)))
        tp = tp.reshape(bsz, nblk + 2, BLOCK, B_KV_HEADS, HEAD_DIM)
        return jnp.concatenate([tp[:, :-2], tp[:, 1:-1], tp[:, 2:]], axis=2)

    kb, vb = band(k), band(v)
    s = jnp.einsum('bnqkgd,bnskd->bnkgqs', qb, kb,
                   preferred_element_type=jnp.float32) * (HEAD_DIM ** -0.5)
    qi = jnp.arange(BLOCK)
    kj = jnp.arange(3 * BLOCK)
    rel = kj[None, :] - BLOCK - qi[:, None]
    bias = rel_bias.astype(jnp.float32)[_t5_bucket(rel)]
    bias = jnp.transpose(bias, (2, 0, 1)).reshape(B_KV_HEADS, grp, BLOCK, 3 * BLOCK)
    kpos = (jnp.arange(nblk)[:, None] - 1) * BLOCK + kj[None, :]
    valid = (kpos >= 0) & (kpos < seq)
    mask = (jnp.abs(rel) <= WINDOW)[None] & valid[:, None, :]
    s = jnp.where(mask[None, :, None, None], s + bias, NEG_INF)
    sink_col = jnp.broadcast_to(sink.astype(jnp.float32).reshape(B_KV_HEADS, grp, 1, 1),
                                s.shape[:-1] + (1,))
    p = jax.nn.softmax(jnp.concatenate([s, sink_col], axis=-1), axis=-1)[..., :-1]
    o = jnp.einsum('bnkgqs,bnskd->bnqkgd', p.astype(vb.dtype), vb)
    return o.reshape(bsz, seq, B_WIDTH)


def _conformer_conv(z, w_dw, b_dw, ln_g, ln_b):
    a, g = jnp.split(z, 2, axis=-1)
    y = a * jax.nn.sigmoid(g)
    pad = CONV_WIDTH // 2
    y = lax.conv_general_dilated(y, w_dw[:, None, :], window_strides=(1,), padding=[(pad, pad)],
                                 dimension_numbers=('NWC', 'WIO', 'NWC'),
                                 feature_group_count=C_WIDTH) + b_dw
    return jax.nn.silu(_layer_norm(y, ln_g, ln_b))


def _route(h, router_w, router_bias):
    scores = jax.nn.sigmoid(jnp.einsum('td,de->te', h, router_w,
                                       preferred_element_type=jnp.float32))
    sel = (scores + router_bias.astype(jnp.float32)).reshape(-1, N_GROUPS, EXPERTS_PER_GROUP)
    group_score = jnp.sum(lax.top_k(sel, TOP_K)[0], axis=-1)
    g_idx = jnp.argmax(group_score, axis=-1).astype(jnp.int32)
    in_group = jnp.take_along_axis(sel, g_idx[:, None, None], axis=1)[:, 0]
    _, local = lax.top_k(in_group, TOP_K)
    expert = (g_idx[:, None] * EXPERTS_PER_GROUP + local).astype(jnp.int32)
    gates = jnp.take_along_axis(scores, expert, axis=1)
    gates = gates / jnp.sum(gates, axis=-1, keepdims=True)
    return expert, gates


def _moe(h, router_w, router_bias, w_gate, w_up, w_down):
    bsz, seq, d = h.shape
    t = bsz * seq
    hf = h.reshape(t, d)
    expert, gates = _route(hf, router_w, router_bias)
    tk = t * TOP_K
    e_flat = expert.reshape(tk)
    tok_flat = jnp.repeat(jnp.arange(t, dtype=jnp.int32), TOP_K)
    g_flat = gates.reshape(tk)
    order = jnp.argsort(e_flat)
    e_s, tok_s, g_s = e_flat[order], tok_flat[order], g_flat[order]
    counts = jnp.bincount(e_flat, length=N_EXPERTS)
    padded = (counts + MOE_BLOCK - 1) // MOE_BLOCK * MOE_BLOCK
    start = jnp.cumsum(counts) - counts
    pend = jnp.cumsum(padded)
    pstart = pend - padded
    dest = pstart[e_s] + jnp.arange(tk, dtype=jnp.int32) - start[e_s]
    n_blocks = -(-tk // MOE_BLOCK) + N_EXPERTS
    rows = n_blocks * MOE_BLOCK
    buf_tok = jnp.zeros((rows,), jnp.int32).at[dest].set(tok_s)
    buf_g = jnp.zeros((rows,), jnp.float32).at[dest].set(g_s)
    block_expert = jnp.minimum(
        jnp.searchsorted(pend, jnp.arange(n_blocks) * MOE_BLOCK, side='right'),
        N_EXPERTS - 1).astype(jnp.int32)
    xin = hf[buf_tok].reshape(n_blocks, MOE_BLOCK, d)

    def expert_block(args):
        xb, e = args
        return (jax.nn.silu(xb @ w_gate[e]) * (xb @ w_up[e])) @ w_down[e]

    yb = lax.map(expert_block, (xin, block_expert))
    out = jnp.zeros((t, d), h.dtype).at[buf_tok].add(
        yb.reshape(rows, d) * buf_g[:, None].astype(h.dtype))
    return out.reshape(bsz, seq, d)


def setup_inputs(seed: int = 0) -> dict:
    key = jax.random.key(seed)
    ks = iter(jax.random.split(key, 40))

    def nrm(shape, s=1.0):
        return s * jax.random.normal(next(ks), shape, jnp.float32)

    L = DEPTH
    return {
        'x': nrm((BATCH, SEQ, D_MODEL)),
        'c': nrm((BATCH, D_MODEL)),
        'ada_w': nrm((L, D_MODEL, 6 * D_MODEL), ADA_SCALE * D_MODEL ** -0.5),
        'ada_b': nrm((L, 6 * D_MODEL), 0.02),
        'w_in': nrm((L, D_MODEL, IN_WIDTH), D_MODEL ** -0.5),
        'b_in': nrm((L, IN_WIDTH), 0.02),
        'gmlp_ln_g': 1.0 + nrm((L, A_WIDTH), 0.02),
        'gmlp_ln_b': nrm((L, A_WIDTH), 0.02),
        'gmlp_ws': nrm((L, A_HEADS, CHUNK, CHUNK), CHUNK ** -0.5),
        'gmlp_bs': 1.0 + nrm((L, A_HEADS, CHUNK), 0.02),
        'attn_sink': nrm((L, B_HEADS), 0.5),
        'conv_w': nrm((L, CONV_WIDTH, C_WIDTH), CONV_WIDTH ** -0.5),
        'conv_b': nrm((L, C_WIDTH), 0.02),
        'conv_ln_g': 1.0 + nrm((L, C_WIDTH), 0.02),
        'conv_ln_b': nrm((L, C_WIDTH), 0.02),
        'w_out': nrm((L, MIX_WIDTH, D_MODEL), BETA * MIX_WIDTH ** -0.5),
        'b_out': nrm((L, D_MODEL), 0.02),
        'ln_mix_g': 1.0 + nrm((L, D_MODEL), 0.02),
        'ln_mix_b': nrm((L, D_MODEL), 0.02),
        'w_gate': nrm((L, N_EXPERTS, D_MODEL, D_EXPERT), D_MODEL ** -0.5),
        'w_up': nrm((L, N_EXPERTS, D_MODEL, D_EXPERT), D_MODEL ** -0.5),
        'w_down': nrm((L, N_EXPERTS, D_EXPERT, D_MODEL), BETA * D_EXPERT ** -0.5),
        'ln_ffn_g': 1.0 + nrm((L, D_MODEL), 0.02),
        'ln_ffn_b': nrm((L, D_MODEL), 0.02),
        'rel_bias': nrm((N_BUCKETS, B_HEADS), 0.5),
        'router_w': nrm((D_MODEL, N_EXPERTS), D_MODEL ** -0.5),
        'router_bias': nrm((N_EXPERTS,), 0.01),
    }


def reference(x, c, ada_w, ada_b, w_in, b_in, gmlp_ln_g, gmlp_ln_b, gmlp_ws, gmlp_bs,
              attn_sink, conv_w, conv_b, conv_ln_g, conv_ln_b, w_out, b_out,
              ln_mix_g, ln_mix_b, w_gate, w_up, w_down, ln_ffn_g, ln_ffn_b,
              rel_bias, router_w, router_bias):
    bsz, seq, _ = x.shape
    i1 = 2 * A_WIDTH
    i2 = i1 + B_WIDTH
    i3 = i2 + KV_WIDTH
    i4 = i3 + KV_WIDTH
    for l in range(DEPTH):
        mod = jnp.einsum('bd,de->be', jax.nn.silu(c), ada_w[l]) + ada_b[l]
        sh1, sc1, g1, sh2, sc2, g2 = jnp.split(mod[:, None, :], 6, axis=-1)

        h = x * (1.0 + sc1) + sh1
        z = h @ w_in[l] + b_in[l]
        ya = _spatial_gating(jax.nn.gelu(z[..., :i1]), gmlp_ln_g[l], gmlp_ln_b[l],
                             gmlp_ws[l], gmlp_bs[l])
        q = z[..., i1:i2].reshape(bsz, seq, B_HEADS, HEAD_DIM)
        k = z[..., i2:i3].reshape(bsz, seq, B_KV_HEADS, HEAD_DIM)
        v = z[..., i3:i4].reshape(bsz, seq, B_KV_HEADS, HEAD_DIM)
        yb = _banded_gqa(q, k, v, attn_sink[l], rel_bias)
        yc = _conformer_conv(z[..., i4:], conv_w[l], conv_b[l], conv_ln_g[l], conv_ln_b[l])
        y = jnp.concatenate([ya, yb, yc], axis=-1) @ w_out[l] + b_out[l]
        x = _layer_norm(ALPHA * x + (1.0 + g1) * y, ln_mix_g[l], ln_mix_b[l])

        h = x * (1.0 + sc2) + sh2
        y = _moe(h, router_w, router_bias, w_gate[l], w_up[l], w_down[l])
        x = _layer_norm(ALPHA * x + (1.0 + g2) * y, ln_ffn_g[l], ln_ffn_b[l])
    return x
```

```cpp
#include <hip/hip_runtime.h>
#include <hip/hip_cooperative_groups.h>
#include <cstdint>
#include <cstdio>
namespace cg = cooperative_groups;

#ifndef REP_MASK
#define REP_MASK 0x0
#endif
#ifndef SPARE_CONV
#define SPARE_CONV 1
#endif
#ifndef MK_ONE_LAUNCH
#define MK_ONE_LAUNCH 1
#endif

#define LAS __attribute__((address_space(3)))
#define GAS __attribute__((address_space(1)))
typedef unsigned short bf16_t;
typedef short bf16x8 __attribute__((ext_vector_type(8)));
typedef short s16x4 __attribute__((ext_vector_type(4)));
typedef short v4i16_t __attribute__((ext_vector_type(4)));
typedef float f32x2 __attribute__((ext_vector_type(2)));
typedef float f32x4 __attribute__((ext_vector_type(4)));
typedef float f32x16 __attribute__((ext_vector_type(16)));
typedef unsigned u32x2 __attribute__((ext_vector_type(2)));
typedef unsigned u32x4 __attribute__((ext_vector_type(4)));
typedef int i32x4 __attribute__((ext_vector_type(4)));
typedef int i32x8 __attribute__((ext_vector_type(8)));
typedef __bf16 bf16x2_t __attribute__((ext_vector_type(2)));

constexpr int NB = 8, SEQ = 4096, DM = 1024, NT = NB * SEQ, NL = 2;
constexpr int INW = 1792, ZW = 1536, NE = 32, DE = 512;
constexpr int NSLOT = 73728;
constexpr float ALPHA = 1.4142135623730951f;
constexpr float LN_EPS = 1e-5f;
constexpr float LOG2E = 1.4426950408889634f;
constexpr float QSCALE = 0.125f * LOG2E;
constexpr float S_H8 = 16.f, S_W8 = 256.f, S_ACT8 = 8.f, S_Y8 = 32.f, S_YC8 = 8.f;

constexpr size_t MiB = 1u << 20;
constexpr size_t WS_CTL = 0, CTL_BYTES = 1 * MiB + 512 * 1024;
constexpr size_t WS_MOD = 1 * MiB;
constexpr size_t WS_BTAB = 1 * MiB + 512 * 1024;
constexpr size_t WS_WSB = 1 * MiB + 768 * 1024;
constexpr size_t WS_RINFO = 2 * MiB;
constexpr size_t WS_RGATE = 3 * MiB;
constexpr size_t WS_LIST = 4 * MiB;
constexpr size_t WS_WIN = 12 * MiB;
constexpr size_t WS_WOUT = 16 * MiB;
constexpr size_t WS_WGU = 18 * MiB;
constexpr size_t WS_H8 = 50 * MiB;
constexpr size_t WS_WD = 82 * MiB;
constexpr size_t WS_H = 114 * MiB;
constexpr size_t WS_R = 178 * MiB;
constexpr size_t WS_XB = 242 * MiB;
constexpr size_t WS_ARENA = 306 * MiB;
constexpr size_t WS_Z = WS_ARENA;
constexpr size_t WS_YCAT = WS_ARENA + 128 * MiB;
constexpr size_t WS_YE = WS_ARENA;
constexpr size_t WS_ACT = WS_ARENA + 144 * MiB;
constexpr size_t WS_WGU1 = WS_ARENA + 216 * MiB;
constexpr size_t WS_WD1 = 98 * MiB;
constexpr size_t WS_END = WS_ARENA + 248 * MiB;
constexpr int CW_CNT = 8192;
constexpr int CW_BAR = 4096;

constexpr int RING_BYTES = 131072;
constexpr int LDS_TOK = RING_BYTES;
constexpr int LDS_TS = RING_BYTES + 8192;
constexpr int LDS_MISC = 147200;
constexpr int LDS_BYTES = 147456;

__device__ __forceinline__ unsigned cvtpk(float lo, float hi) { f32x2 v = {lo, hi}; bf16x2_t b = __builtin_convertvector(v, bf16x2_t); return __builtin_bit_cast(unsigned, b); }
#ifndef FP8_ASM_CLAMP
#define FP8_ASM_CLAMP 1
#endif
__device__ __forceinline__ unsigned cvt4_fp8(float a, float b, float c, float d) {
#if FP8_ASM_CLAMP
    int w = __builtin_amdgcn_cvt_pk_fp8_f32(a, b, 0, false); w = __builtin_amdgcn_cvt_pk_fp8_f32(c, d, w, true); return (unsigned)w;
#else
    a = __builtin_amdgcn_fmed3f(a, -448.f, 448.f); b = __builtin_amdgcn_fmed3f(b, -448.f, 448.f); c = __builtin_amdgcn_fmed3f(c, -448.f, 448.f); d = __builtin_amdgcn_fmed3f(d, -448.f, 448.f);
    int w = __builtin_amdgcn_cvt_pk_fp8_f32(a, b, 0, false); w = __builtin_amdgcn_cvt_pk_fp8_f32(c, d, w, true); return (unsigned)w;
#endif
}
__device__ __forceinline__ float bf_lo(unsigned w) { return __uint_as_float(w << 16); }
__device__ __forceinline__ float bf_hi(unsigned w) { return __uint_as_float(w & 0xffff0000u); }
template <int CTRL> __device__ __forceinline__ int dpp_i(int v) { return __builtin_amdgcn_update_dpp(0, v, CTRL, 0xf, 0xf, true); }
__device__ __forceinline__ int swap16_i(int v, int) { const auto r = __builtin_amdgcn_permlane16_swap((unsigned)v, (unsigned)v, false, false); return ((int)r[0] != v) ? (int)r[0] : (int)r[1]; }
__device__ __forceinline__ int swap32_i(int v, int) { const auto r = __builtin_amdgcn_permlane32_swap((unsigned)v, (unsigned)v, false, false); return ((int)r[0] != v) ? (int)r[0] : (int)r[1]; }
template <int M> __device__ __forceinline__ int xlane_i(int v, int lane) {
    if constexpr (M & 32) v = swap32_i(v, lane);
    if constexpr (M & 16) v = swap16_i(v, lane);
    constexpr int m = M & 15;
    if constexpr (m >= 8) { v = dpp_i<0x140>(v); constexpr int m2 = m ^ 15;
        if constexpr (m2 >= 4) { v = dpp_i<0x141>(v); constexpr int m3 = m2 ^ 7; if constexpr (m3 == 1) v = dpp_i<0xB1>(v); else if constexpr (m3 == 2) v = dpp_i<0x4E>(v); else if constexpr (m3 == 3) v = dpp_i<0x1B>(v); }
        else if constexpr (m2 == 1) v = dpp_i<0xB1>(v); else if constexpr (m2 == 2) v = dpp_i<0x4E>(v); else if constexpr (m2 == 3) v = dpp_i<0x1B>(v); }
    else if constexpr (m >= 4) { v = dpp_i<0x141>(v); constexpr int m3 = m ^ 7;
        if constexpr (m3 == 1) v = dpp_i<0xB1>(v); else if constexpr (m3 == 2) v = dpp_i<0x4E>(v); else if constexpr (m3 == 3) v = dpp_i<0x1B>(v); }
    else if constexpr (m == 1) v = dpp_i<0xB1>(v); else if constexpr (m == 2) v = dpp_i<0x4E>(v); else if constexpr (m == 3) v = dpp_i<0x1B>(v);
    return v;
}
template <int M> __device__ __forceinline__ float xlane_f(float v, int lane) { return __int_as_float(xlane_i<M>(__float_as_int(v), lane)); }
__device__ __forceinline__ float sum_halves(float v) { const auto r = __builtin_amdgcn_permlane32_swap(__float_as_uint(v), __float_as_uint(v), false, false); return __uint_as_float(r[0]) + __uint_as_float(r[1]); }
__device__ __forceinline__ float max_halves(float v) { const auto r = __builtin_amdgcn_permlane32_swap(__float_as_uint(v), __float_as_uint(v), false, false); return fmaxf(__uint_as_float(r[0]), __uint_as_float(r[1])); }
__device__ __forceinline__ float wave_sum(float v) {
    v += __int_as_float(dpp_i<0xB1>(__float_as_int(v))); v += __int_as_float(dpp_i<0x4E>(__float_as_int(v)));
    v += __int_as_float(dpp_i<0x141>(__float_as_int(v))); v += __int_as_float(dpp_i<0x140>(__float_as_int(v)));
    { const auto r = __builtin_amdgcn_permlane16_swap(__float_as_uint(v), __float_as_uint(v), false, false); v = __uint_as_float(r[0]) + __uint_as_float(r[1]); }
    return sum_halves(v);
}
__device__ __forceinline__ float fast_exp2(float x) { return __builtin_amdgcn_exp2f(x); }
__device__ __forceinline__ float fast_rcp(float x) { return __builtin_amdgcn_rcpf(x); }
__device__ __forceinline__ float sigmoid_f(float x) { return fast_rcp(1.f + fast_exp2(-LOG2E * x)); }
__device__ __forceinline__ float silu_f(float x) { return x * sigmoid_f(x); }
__device__ __forceinline__ float gelu_tanh_f(float x) {
    const float u = x * (1.f + 0.044715f * x * x);
    return x * fast_rcp(1.f + fast_exp2(-2.f * 0.7978845608028654f * LOG2E * u));
}
__device__ __forceinline__ int phase_tid() { int t = threadIdx.x; asm volatile("" : "+v"(t)); return t; }
#define RCOL(lane, j) (16 * (lane) + 4 * (j))
#ifndef ST16_AUX
#define ST16_AUX 0
#endif
__device__ __forceinline__ void st16_wt(const void* base, unsigned off, u32x4 v) {
    const __amdgpu_buffer_rsrc_t r = __builtin_amdgcn_make_buffer_rsrc((void*)base, (short)0, 0x7ffff000, 0x00020000);
    __builtin_amdgcn_raw_buffer_store_b128(v, r, off, 0,   ST16_AUX); }
__device__ __forceinline__ u32x4 ld16_buf(const void* base, unsigned voff, unsigned soff) {
    const __amdgpu_buffer_rsrc_t r = __builtin_amdgcn_make_buffer_rsrc((void*)base, (short)0, 0x7ffff000, 0x00020000);
    return __builtin_amdgcn_raw_buffer_load_b128(r, voff, soff, 0); }
#define LDS_WAIT() asm volatile("s_waitcnt lgkmcnt(0)" ::: "memory")
#define VM_WAIT() asm volatile("s_waitcnt vmcnt(0)" ::: "memory")

namespace pg8 {
constexpr int BM = 256, BK = 64, HALF = 128, HTB = HALF * BK * 2, NXCD = 8, WGM = 8;
__host__ __device__ __forceinline__ int lds_byte(int r, int c) { const int st = (r >> 4) * 2 + (c >> 5), rr = r & 15, cc = c & 31, ob = rr * 64 + cc * 2; return st * 1024 + (ob ^ (((ob >> 9) & 1) << 5)); }
__host__ __device__ __forceinline__ void stage_rc(int b, int& R, int& C) { const int st = b / 1024, sb = b % 1024, swz = sb ^ (((sb >> 9) & 1) << 5); R = (st >> 1) * 16 + swz / 64; C = (st & 1) * 32 + (swz % 64) / 2; }
__host__ __device__ __forceinline__ int perm32(int rho) { const int n = rho >> 4, i = rho & 15; return 8 * (i >> 2) + 4 * n + (i & 3); }

struct GUnit { const char* A; const char* B; int orow; int pn; int aux; int tokoff; };

struct DenseOrder {
    const char* Abase; const char* Bbase; int RB; int nM, nN, nwg, G, c; bool gather = false;
    __device__ __forceinline__ void init(const void* A, const void* Bt, int M, int N, int K_, int G_, int c_) { Abase = (const char*)A; Bbase = (const char*)Bt; RB = K_ * 2; nM = M / BM; nN = N / BM; nwg = nM * nN; G = G_; c = c_; }
    __device__ __forceinline__ bool next(int i, GUnit& u) const {
        const long L = (long)i * G + c; if (L >= nwg) return false;
        int wgid = (int)L; { const int q = nwg / NXCD, r = nwg % NXCD, xcd = wgid % NXCD, off = wgid / NXCD; wgid = (xcd < r ? xcd * (q + 1) : r * (q + 1) + (xcd - r) * q) + off; }
        const int nig = WGM * nN, gid = wgid / nig, fm = gid * WGM, gsz = (nM - fm) < WGM ? (nM - fm) : WGM;
        const int pm = fm + ((wgid % nig) % gsz), pn = (wgid % nig) / gsz;
        u.A = gather ? Abase : Abase + (size_t)pm * BM * RB; u.B = Bbase + (size_t)pn * BM * RB; u.orow = pm * BM; u.pn = pn; u.aux = 0; u.tokoff = i * 1024; return true;
    }
};

template <class Epi, class Sched, bool GATHER, bool FP8 = false, bool EPI2 = false>
__device__ __forceinline__ void gemm_phase(LAS unsigned char* lds, LAS unsigned char* toklds, const int RB, const Sched& S, const Epi& E) {
    const int tid = phase_tid(), wid = __builtin_amdgcn_readfirstlane(tid >> 6), lane = tid & 63, wr = wid >> 2, wc = wid & 3, fr = lane & 15, fq = lane >> 4;
    int nt = RB / 128; asm volatile("" : "+s"(nt));
    unsigned voffA[2][2], voffB[2]; int rowA[2], colA2[2];
#pragma unroll
    for (int i = 0; i < 2; ++i) { int R, C; stage_rc(tid * 16 + i * 8192, R, C); const int Rb = Epi::PERM ? ((R & ~31) + perm32(R & 31)) : R;
        rowA[i] = R; colA2[i] = C * 2;
        voffA[0][i] = (unsigned)(R * RB + C * 2); voffA[1][i] = (unsigned)((R + HALF) * RB + C * 2); voffB[i] = (unsigned)(Rb * RB + C * 2); }
    const size_t kstep = (size_t)(BK * 2);
    const size_t hstep = (size_t)HALF * RB;
    const unsigned ldsw = (unsigned)wid * 1024u;
    const int aoff = lds_byte(wr * 64 + fr, fq * 8), boff = lds_byte(wc * 32 + fr, fq * 8);
#define PG8_SA(b, h) (((b) * 2 + (h)) * HTB)
#define PG8_SB(b, h) ((4 + (b) * 2 + (h)) * HTB)
#define PG8_STAGE(bufoff, gbase, voff) do { _Pragma("unroll") for (int _i = 0; _i < 2; ++_i) \
        __builtin_amdgcn_global_load_lds((const unsigned*)((const char*)(gbase) + (voff)[_i]), (LAS unsigned*)(lds + (bufoff) + ldsw + _i * 8192), 16, 0, 0); } while (0)
#define PG8_LDA(dst, b, h) do { _Pragma("unroll") for (int m = 0; m < 4; ++m) _Pragma("unroll") for (int k = 0; k < 2; ++k) dst[m][k] = *(const LAS bf16x8*)(lds + PG8_SA(b, h) + aoff + m * 2048 + k * 1024); } while (0)
#define PG8_LDB(dst, b, h) do { _Pragma("unroll") for (int n = 0; n < 2; ++n) _Pragma("unroll") for (int k = 0; k < 2; ++k) dst[n][k] = *(const LAS bf16x8*)(lds + PG8_SB(b, h) + boff + n * 2048 + k * 1024); } while (0)
#define PG8_MMA(ai, bj, At, Bt) do { __builtin_amdgcn_s_setprio(1); if constexpr (FP8) { _Pragma("unroll") for (int m = 0; m < 4; ++m) _Pragma("unroll") for (int n = 0; n < 2; ++n) { \
            const i32x8 bo_ = __builtin_shufflevector(__builtin_bit_cast(i32x4, Bt[n][0]), __builtin_bit_cast(i32x4, Bt[n][1]), 0, 1, 2, 3, 4, 5, 6, 7); \
            const i32x8 ao_ = __builtin_shufflevector(__builtin_bit_cast(i32x4, At[m][0]), __builtin_bit_cast(i32x4, At[m][1]), 0, 1, 2, 3, 4, 5, 6, 7); \
            acc[ai][bj][m][n] = __builtin_amdgcn_mfma_scale_f32_16x16x128_f8f6f4(bo_, ao_, acc[ai][bj][m][n], 0, 0, 0, 0x7F7F7F7F, 0, 0x7F7F7F7F); } } \
        else { _Pragma("unroll") for (int m = 0; m < 4; ++m) _Pragma("unroll") for (int n = 0; n < 2; ++n) _Pragma("unroll") for (int k = 0; k < 2; ++k) \
            acc[ai][bj][m][n] = __builtin_amdgcn_mfma_f32_16x16x32_bf16(Bt[n][k], At[m][k], acc[ai][bj][m][n], 0, 0, 0); } __builtin_amdgcn_s_setprio(0); } while (0)
#define PG8_WAIT_V(n) asm volatile("s_waitcnt vmcnt(" #n ")" ::: "memory")
#define PG8_WAIT_L(n) asm volatile("s_waitcnt lgkmcnt(" #n ")" ::: "memory")
#define PG8_BAR __builtin_amdgcn_s_barrier()
#define PG8_SCHED __builtin_amdgcn_sched_barrier(0)
#define PG8_GATHER_OFFS(u_) do { if constexpr (GATHER) { _Pragma("unroll") for (int _h = 0; _h < 2; ++_h) _Pragma("unroll") for (int _i = 0; _i < 2; ++_i) { \
        const int _tok = *(const LAS int*)(toklds + (u_).tokoff + (_h * HALF + rowA[_i]) * 4); voffA[_h][_i] = (unsigned)_tok * (unsigned)RB + (unsigned)colA2[_i]; } } } while (0)
    GUnit cur, nxt; int ui = 0;
    if (!S.next(0, cur)) return;
    f32x4 acc[2][2][4][2];
#pragma unroll
    for (int a = 0; a < 2; ++a)
#pragma unroll
        for (int b = 0; b < 2; ++b)
#pragma unroll
            for (int m = 0; m < 4; ++m)
#pragma unroll
                for (int n = 0; n < 2; ++n) acc[a][b][m][n] = (f32x4){0.f, 0.f, 0.f, 0.f};
    bf16x8 At[4][2], B0[2][2], B1[2][2];
    const char* cA = cur.A; const char* cB = cur.B;
    asm volatile("" : "+s"(cA), "+s"(cB));
    PG8_GATHER_OFFS(cur);
    PG8_STAGE(PG8_SB(0, 0), cB, voffB); PG8_STAGE(PG8_SB(0, 1), cB + hstep, voffB); PG8_STAGE(PG8_SA(0, 0), cA, voffA[0]); PG8_STAGE(PG8_SA(0, 1), cA, voffA[1]);
    if (wr == 1) PG8_BAR;
    PG8_WAIT_V(2); PG8_BAR;
    PG8_STAGE(PG8_SB(1, 0), cB + kstep, voffB); PG8_STAGE(PG8_SA(1, 0), cA + kstep, voffA[0]); PG8_STAGE(PG8_SB(1, 1), cB + hstep + kstep, voffB);
    PG8_WAIT_V(6); PG8_BAR;
    for (;;) {
        asm volatile("" : "+v"(voffA[0][0]), "+v"(voffA[0][1]), "+v"(voffA[1][0]), "+v"(voffA[1][1]), "+v"(voffB[0]), "+v"(voffB[1]));
        const bool has_next = S.next(ui + 1, nxt);
        const char* nA = has_next ? nxt.A : cA; const char* nB = has_next ? nxt.B : cB;
#pragma unroll 1
        for (int t = 0; t < nt; t += 2) {
            const bool last = (t == nt - 2);
            const char* a1 = cA + (size_t)(t + 1) * kstep;
            const char* a2 = last ? nA : cA + (size_t)(t + 2) * kstep; const char* b2 = last ? nB : cB + (size_t)(t + 2) * kstep;
            const char* a3 = a2 + kstep; const char* b3 = b2 + kstep;
            PG8_LDB(B0, 0, 0); PG8_LDB(B1, 0, 1); PG8_SCHED; PG8_LDA(At, 0, 0); PG8_STAGE(PG8_SA(1, 1), a1, voffA[1]);
            if (GATHER && last && has_next) { PG8_GATHER_OFFS(nxt); }
            PG8_WAIT_V(8); PG8_WAIT_L(0); PG8_BAR; PG8_MMA(0, 0, At, B0); PG8_MMA(0, 1, At, B1); PG8_BAR; PG8_SCHED;
            PG8_LDA(At, 0, 1); PG8_STAGE(PG8_SB(0, 0), b2, voffB); PG8_STAGE(PG8_SB(0, 1), b2 + hstep, voffB); PG8_STAGE(PG8_SA(0, 0), a2, voffA[0]);
            PG8_WAIT_V(8); PG8_WAIT_L(0); PG8_BAR; PG8_MMA(1, 0, At, B0); PG8_MMA(1, 1, At, B1); PG8_BAR; PG8_SCHED;
            PG8_LDB(B0, 1, 0); PG8_LDB(B1, 1, 1); PG8_SCHED; PG8_LDA(At, 1, 0); PG8_STAGE(PG8_SA(0, 1), a2, voffA[1]);
            PG8_WAIT_V(8); PG8_WAIT_L(0); PG8_BAR; PG8_MMA(0, 0, At, B0); PG8_MMA(0, 1, At, B1); PG8_BAR; PG8_SCHED;
            PG8_LDA(At, 1, 1); PG8_STAGE(PG8_SB(1, 0), b3, voffB); PG8_STAGE(PG8_SB(1, 1), b3 + hstep, voffB); PG8_STAGE(PG8_SA(1, 0), a3, voffA[0]);
            PG8_WAIT_V(8); PG8_WAIT_L(0); PG8_BAR; PG8_MMA(1, 0, At, B0); PG8_MMA(1, 1, At, B1); PG8_BAR; PG8_SCHED;
        }
        if (wr == 0) PG8_BAR;
        E(acc, cur, wr, wc, fr, fq);
        if constexpr (EPI2) { asm volatile("" ::: "memory"); E(acc, cur, wr, wc, fr, fq); }
        if (!has_next) break;
#pragma unroll
        for (int a = 0; a < 2; ++a)
#pragma unroll
            for (int b = 0; b < 2; ++b)
#pragma unroll
                for (int m = 0; m < 4; ++m)
#pragma unroll
                    for (int n = 0; n < 2; ++n) acc[a][b][m][n] = (f32x4){0.f, 0.f, 0.f, 0.f};
        cur = nxt; cA = nA; cB = nB; ++ui;
        if (wr == 1) PG8_BAR;
    }
    PG8_WAIT_V(0);
    PG8_BAR;
#undef PG8_SA
#undef PG8_SB
#undef PG8_STAGE
#undef PG8_LDA
#undef PG8_LDB
#undef PG8_MMA
#undef PG8_WAIT_V
#undef PG8_WAIT_L
#undef PG8_BAR
#undef PG8_SCHED
#undef PG8_GATHER_OFFS
}
}

struct EpiInProj {
    static constexpr bool PERM = true;
    bf16_t* Z; const float* bias; float us;
    template <int MODE>
    __device__ __forceinline__ void plain(const f32x4 (&acc)[2][2][4][2], const pg8::GUnit& u, int wr, int wc, int fr, int fq) const {
        const int row0 = u.orow + wr * 64 + fr; const int cw = u.pn * 256 + wc * 32 + 8 * fq;
        f32x4 bb0[2], bb1[2];
#pragma unroll
        for (int bj = 0; bj < 2; ++bj) { bb0[bj] = *(const f32x4*)(bias + cw + bj * 128); bb1[bj] = *(const f32x4*)(bias + cw + bj * 128 + 4); }
#pragma unroll
        for (int bj = 0; bj < 2; ++bj) {
            const f32x4 b0 = bb0[bj], b1 = bb1[bj];
#pragma unroll
            for (int ai = 0; ai < 2; ++ai)
#pragma unroll
                for (int m = 0; m < 4; ++m) { f32x4 v0 = acc[ai][bj][m][0] * us + b0, v1 = acc[ai][bj][m][1] * us + b1;
                    if (MODE == 0) {
#pragma unroll
                        for (int j = 0; j < 4; ++j) { v0[j] = gelu_tanh_f(v0[j]); v1[j] = gelu_tanh_f(v1[j]); }
                    } else if (MODE == 1) { v0 = v0 * QSCALE; v1 = v1 * QSCALE; }
                    u32x4 w; w.x = cvtpk(v0[0], v0[1]); w.y = cvtpk(v0[2], v0[3]); w.z = cvtpk(v1[0], v1[1]); w.w = cvtpk(v1[2], v1[3]);
                    st16_wt(Z, (unsigned)(((row0 + ai * 128 + m * 16) * ZW + cw + bj * 128) * 2), w); }
            asm volatile("" ::: "memory");
        }
    }
    __device__ __forceinline__ void glu(const f32x4 (&acc)[2][2][4][2], const pg8::GUnit& u, int wr, int wc, int fr, int fq) const {
        const int row0 = u.orow + wr * 64 + fr; const int h0 = (u.pn - 5) * 128 + wc * 32 + 8 * fq;
        const f32x4 ba0 = *(const f32x4*)(bias + 1280 + h0), ba1 = *(const f32x4*)(bias + 1280 + h0 + 4), bg0 = *(const f32x4*)(bias + 1536 + h0), bg1 = *(const f32x4*)(bias + 1536 + h0 + 4);
#pragma unroll
        for (int ai = 0; ai < 2; ++ai)
#pragma unroll
            for (int m = 0; m < 4; ++m) {
                const f32x4 a0 = acc[ai][0][m][0] * us + ba0, a1 = acc[ai][0][m][1] * us + ba1, g0 = acc[ai][1][m][0] * us + bg0, g1 = acc[ai][1][m][1] * us + bg1;
                f32x4 y0, y1;
#pragma unroll
                for (int j = 0; j < 4; ++j) { y0[j] = a0[j] * sigmoid_f(g0[j]); y1[j] = a1[j] * sigmoid_f(g1[j]); }
                u32x4 w; w.x = cvtpk(y0[0], y0[1]); w.y = cvtpk(y0[2], y0[3]); w.z = cvtpk(y1[0], y1[1]); w.w = cvtpk(y1[2], y1[3]);
                st16_wt(Z, (unsigned)(((row0 + ai * 128 + m * 16) * ZW + 1280 + h0) * 2), w); }
    }
    __device__ __forceinline__ void operator()(const f32x4 (&acc)[2][2][4][2], const pg8::GUnit& u, int wr, int wc, int fr, int fq) const {
        const int pn = u.pn;
        if (pn < 2) plain<0>(acc, u, wr, wc, fr, fq); else if (pn < 4) plain<1>(acc, u, wr, wc, fr, fq); else if (pn == 4) plain<2>(acc, u, wr, wc, fr, fq); else glu(acc, u, wr, wc, fr, fq);
    }
};
struct EpiOutProj {
    static constexpr bool PERM = true;
    bf16_t* R; const float* xf; const bf16_t* xb; const float* bias; const float* gmod;
    __device__ __forceinline__ void operator()(const f32x4 (&acc)[2][2][4][2], const pg8::GUnit& u, int wr, int wc, int fr, int fq) const {
        const int row0 = u.orow + wr * 64 + fr, col0 = u.pn * 256 + wc * 32 + 8 * fq; const int b = u.orow >> 12; constexpr float US = 1.0f / (S_YC8 * S_W8);
        if (xf) {
#pragma unroll
            for (int bj = 0; bj < 2; ++bj) { const int c = col0 + bj * 128;
                const f32x4 b0 = *(const f32x4*)(bias + c), b1 = *(const f32x4*)(bias + c + 4), g0 = *(const f32x4*)(gmod + b * 6144 + c) + 1.0f, g1 = *(const f32x4*)(gmod + b * 6144 + c + 4) + 1.0f;
                f32x4 x0[2][4], x1[2][4];
#pragma unroll
                for (int ai = 0; ai < 2; ++ai)
#pragma unroll
                    for (int m = 0; m < 4; ++m) { const unsigned vo = (unsigned)((row0 * DM + c) * 4), so = (unsigned)((ai * 128 + m * 16) * DM * 4); x0[ai][m] = __builtin_bit_cast(f32x4, ld16_buf(xf, vo, so)); x1[ai][m] = __builtin_bit_cast(f32x4, ld16_buf(xf, vo + 16, so)); }
#pragma unroll
                for (int ai = 0; ai < 2; ++ai)
#pragma unroll
                    for (int m = 0; m < 4; ++m) { const size_t off = (size_t)(row0 + ai * 128 + m * 16) * DM + c;
                        const f32x4 r0 = x0[ai][m] * ALPHA + g0 * (acc[ai][bj][m][0] * US + b0), r1 = x1[ai][m] * ALPHA + g1 * (acc[ai][bj][m][1] * US + b1);
                        u32x4 o; o.x = cvtpk(r0[0], r0[1]); o.y = cvtpk(r0[2], r0[3]); o.z = cvtpk(r1[0], r1[1]); o.w = cvtpk(r1[2], r1[3]);
                        st16_wt(R, (unsigned)(off * 2), o); }
                asm volatile("" ::: "memory"); }
        } else { u32x4 w[2][2][4]; f32x4 pb[2][4];
#pragma unroll
            for (int bj = 0; bj < 2; ++bj) { const int c = col0 + bj * 128;
                pb[bj][0] = *(const f32x4*)(bias + c); pb[bj][1] = *(const f32x4*)(bias + c + 4); pb[bj][2] = *(const f32x4*)(gmod + b * 6144 + c) + 1.0f; pb[bj][3] = *(const f32x4*)(gmod + b * 6144 + c + 4) + 1.0f;
#pragma unroll
                for (int ai = 0; ai < 2; ++ai)
#pragma unroll
                    for (int m = 0; m < 4; ++m) w[bj][ai][m] = ld16_buf(xb, (unsigned)((row0 * DM + c) * 2), (unsigned)((ai * 128 + m * 16) * DM * 2)); }
#pragma unroll
            for (int bj = 0; bj < 2; ++bj) { const int c = col0 + bj * 128;
#pragma unroll
                for (int ai = 0; ai < 2; ++ai)
#pragma unroll
                    for (int m = 0; m < 4; ++m) { const size_t off = (size_t)(row0 + ai * 128 + m * 16) * DM + c; const u32x4 ww = w[bj][ai][m];
                        const f32x4 x0 = (f32x4){bf_lo(ww.x), bf_hi(ww.x), bf_lo(ww.y), bf_hi(ww.y)}, x1 = (f32x4){bf_lo(ww.z), bf_hi(ww.z), bf_lo(ww.w), bf_hi(ww.w)};
                        const f32x4 r0 = x0 * ALPHA + pb[bj][2] * (acc[ai][bj][m][0] * US + pb[bj][0]), r1 = x1 * ALPHA + pb[bj][3] * (acc[ai][bj][m][1] * US + pb[bj][1]);
                        u32x4 o; o.x = cvtpk(r0[0], r0[1]); o.y = cvtpk(r0[2], r0[3]); o.z = cvtpk(r1[0], r1[1]); o.w = cvtpk(r1[2], r1[3]);
                        st16_wt(R, (unsigned)(off * 2), o); } }
            asm volatile("" ::: "memory"); }
    }
};
struct EpiGateUp {
    static constexpr bool PERM = true;
    unsigned char* ACT;
    __device__ __forceinline__ void operator()(const f32x4 (&acc)[2][2][4][2], const pg8::GUnit& u, int wr, int wc, int fr, int fq) const {
        const int row0 = u.orow + wr * 64 + fr; const int c0 = u.pn * 128 + wc * 32 + 8 * fq; constexpr float us = 1.0f / (S_H8 * S_W8);
#pragma unroll
        for (int ai = 0; ai < 2; ++ai)
#pragma unroll
            for (int mp = 0; mp < 4; mp += 2) { u32x2 w[2];
#pragma unroll
                for (int t = 0; t < 2; ++t) { const int m = mp + t; f32x4 y[2];
#pragma unroll
                    for (int n = 0; n < 2; ++n) { const f32x4 g = acc[ai][0][m][n] * us, up = acc[ai][1][m][n] * (us * S_ACT8);
#pragma unroll
                        for (int j = 0; j < 4; ++j) y[n][j] = silu_f(g[j]) * up[j]; }
                    w[t].x = cvt4_fp8(y[0][0], y[0][1], y[0][2], y[0][3]); w[t].y = cvt4_fp8(y[1][0], y[1][1], y[1][2], y[1][3]); }
                const auto r0 = __builtin_amdgcn_permlane16_swap(w[0].x, w[1].x, false, false), r1 = __builtin_amdgcn_permlane16_swap(w[0].y, w[1].y, false, false);
                st16_wt(ACT, (unsigned)((row0 + ai * 128 + (mp + (fq & 1)) * 16) * DE + (c0 - 8 * (fq & 1))), (u32x4){r0[0], r1[0], r0[1], r1[1]}); }
    }
};
struct EpiDown {
    static constexpr bool PERM = true;
    unsigned char* YE;
    __device__ __forceinline__ void operator()(const f32x4 (&acc)[2][2][4][2], const pg8::GUnit& u, int wr, int wc, int fr, int fq) const {
        const int row0 = u.orow + wr * 64 + fr; const int c0 = u.pn * 256 + wc * 32 + 8 * fq; constexpr float us = S_Y8 / (S_ACT8 * S_W8);
#pragma unroll
        for (int ai = 0; ai < 2; ++ai)
#pragma unroll
            for (int mp = 0; mp < 4; mp += 2) { const unsigned rowp = (unsigned)((row0 + ai * 128 + (mp + (fq & 1)) * 16) * DM + (c0 - 8 * (fq & 1)));
#pragma unroll
                for (int bj = 0; bj < 2; ++bj) { u32x2 w[2];
#pragma unroll
                    for (int t = 0; t < 2; ++t) { const f32x4 v0 = acc[ai][bj][mp + t][0] * us, v1 = acc[ai][bj][mp + t][1] * us;
                        w[t].x = cvt4_fp8(v0[0], v0[1], v0[2], v0[3]); w[t].y = cvt4_fp8(v1[0], v1[1], v1[2], v1[3]); }
                    const auto r0 = __builtin_amdgcn_permlane16_swap(w[0].x, w[1].x, false, false), r1 = __builtin_amdgcn_permlane16_swap(w[0].y, w[1].y, false, false);
                    st16_wt(YE, rowp + bj * 128, (u32x4){r0[0], r1[0], r0[1], r1[1]}); } }
    }
};

struct MoeOrder {
    const char* Abase; const char* Wbase; size_t wstride; int rowbytes; int vcu; int ntile; const LAS int* ue; bool gather;
    __device__ __forceinline__ bool next(int i, pg8::GUnit& u) const {
        if (i >= 8) return false;
        const int Lu = i * 256 + vcu; const int tile = Lu >> 2, pn = Lu & 3; const int e = __builtin_amdgcn_readfirstlane(ue[i]);
        if (e < 0) return false;
        u.A = gather ? Abase : Abase + (size_t)tile * 256 * rowbytes; u.B = Wbase + (size_t)e * wstride + (size_t)pn * 256 * rowbytes;
        u.orow = tile * 256; u.pn = pn; u.aux = e; u.tokoff = i * 1024; return true;
    }
};

#define XB_TMO      128
#define XB_XCNT(j)  (256  + 64 * (j))
#define XB_XSUB(j)  (1280 + 64 * (j))
#define XB_XGEN(j)  (2304 + 64 * (j))
#define XB_TOP      3328
#define XB_TOPGEN   3392
#define XCD_BAR_WORDS 3456
#define XB_SPIN_CAP (1u << 20)
__device__ __forceinline__ unsigned xb_ld(unsigned* p)              { return __hip_atomic_load(p, __ATOMIC_RELAXED, __HIP_MEMORY_SCOPE_AGENT); }
__device__ __forceinline__ unsigned xb_add(unsigned* p, unsigned v) { return __hip_atomic_fetch_add(p, v, __ATOMIC_RELAXED, __HIP_MEMORY_SCOPE_AGENT); }
__device__ __forceinline__ unsigned xb_xcc_id() { return (unsigned)__builtin_amdgcn_s_getreg((3 << 11) | 20) & 0xFu; }
#define XB_SPIN(cond, bar) do { unsigned _sp = 0; while (cond) { __builtin_amdgcn_s_sleep(1); \
    if ((++_sp & 255u) == 0u) { if (xb_ld(&(bar)[XB_TMO])) break; if (_sp > XB_SPIN_CAP) { atomicAdd(&(bar)[XB_TMO], 1u); break; } } } } while (0)
struct XcdBarrier { unsigned* bar; unsigned x; volatile LAS unsigned* st; };
__device__ __forceinline__ XcdBarrier xcd_barrier_post(unsigned* bar, volatile LAS unsigned* st) {
    XcdBarrier b; b.bar = bar; b.x = xb_xcc_id(); b.st = st;
    if (threadIdx.x == 0) (void)xb_add(&bar[XB_XCNT(b.x)], 1u);
    return b;
}
__device__ __forceinline__ void xcd_barrier_complete(unsigned* bar, unsigned x, unsigned& nloc, unsigned& nx) {
    const unsigned G = gridDim.x * gridDim.y * gridDim.z;
    unsigned sum, cnt, mine, sp = 0u;
    for (;;) {
        sum = 0u; cnt = 0u; mine = 0u;
#pragma unroll
        for (unsigned j = 0; j < 16; ++j) { const unsigned c = xb_ld(&bar[XB_XCNT(j)]); sum += c; cnt += (c > 0u) ? 1u : 0u; mine = (j == x) ? c : mine; }
        if (sum == G) break;
        __builtin_amdgcn_s_sleep(1);
        if ((++sp & 255u) == 0u) { if (xb_ld(&bar[XB_TMO])) break; if (sp > XB_SPIN_CAP) { atomicAdd(&bar[XB_TMO], 1u); break; } }
    }
    nloc = mine > 0u ? mine : 1u; nx = cnt > 0u ? cnt : 1u;
}
__device__ __forceinline__ void xcd_barrier(const XcdBarrier& b) {
    asm volatile("s_waitcnt vmcnt(0)" ::: "memory");
    __syncthreads();
    if (phase_tid() == 0) {
        unsigned* bar = b.bar; asm volatile("" : "+s"(bar));
        const unsigned bxc = xb_xcc_id();
        __builtin_amdgcn_s_waitcnt(0);
        unsigned nloc = b.st[0], nx = b.st[1];
        if (nloc == 0u) { xcd_barrier_complete(bar, bxc, nloc, nx); b.st[0] = nloc; b.st[1] = nx; }
        const unsigned old = xb_add(&bar[XB_XSUB(bxc)], 1u);
        const unsigned gen = old / nloc;
        if (old + 1u == (gen + 1u) * nloc) {
            __builtin_amdgcn_fence(__ATOMIC_RELEASE, "agent");
            asm volatile("s_waitcnt vmcnt(0)" ::: "memory");
            const unsigned og = xb_add(&bar[XB_TOP], 1u);
            const unsigned tg = og / nx;
            if (og + 1u == (tg + 1u) * nx) xb_add(&bar[XB_TOPGEN], 1u);
            else XB_SPIN(xb_ld(&bar[XB_TOPGEN]) == tg, bar);
            __builtin_amdgcn_fence(__ATOMIC_ACQUIRE, "agent");
            asm volatile("s_waitcnt vmcnt(0)" ::: "memory");
        } else {
            XB_SPIN(xb_ld(&bar[XB_TOPGEN]) == gen, bar);
            __builtin_amdgcn_fence(__ATOMIC_ACQUIRE, "agent");
            asm volatile("s_waitcnt vmcnt(0)" ::: "memory");
        }
    }
    __syncthreads();
}

struct Params {
    const float* in[27];
    float* out;
    unsigned char* ws;
    int ph_lo, ph_hi;
    int use_bar, never;
};
enum { I_X = 0, I_C, I_ADAW, I_ADAB, I_WIN, I_BIN, I_GLNG, I_GLNB, I_GWS, I_GBS, I_SINK, I_CONVW, I_CONVB, I_CLNG, I_CLNB, I_WOUT, I_BOUT, I_LMG, I_LMB,
       I_WGATE, I_WUP, I_WDOWN, I_LFG, I_LFB, I_RELB, I_RW, I_RB };

template <bool FP8>
__device__ __forceinline__ void transpose_item(const float* W, int N, int k0, int n0, unsigned char* dst0, int ldk, float scale, LAS float* scr, int lane, const unsigned char* wsbase) {
    { const int cq = (lane & 15) * 4, kr = lane >> 4;
      f32x4 v[16];
#pragma unroll
      for (int i = 0; i < 16; ++i) v[i] = *(const f32x4*)(W + (size_t)(k0 + 4 * i + kr) * N + n0 + cq);
#pragma unroll
      for (int i = 0; i < 16; ++i) { LAS float* p = scr + (4 * i + kr) * 65 + cq; p[0] = v[i][0]; p[1] = v[i][1]; p[2] = v[i][2]; p[3] = v[i][3]; } }
    LDS_WAIT(); asm volatile("" ::: "memory");
    if (FP8) { const int c = lane & 3;
#pragma unroll
        for (int j = 0; j < 4; ++j) { const int n = (lane >> 2) + 16 * j; const LAS float* s = scr + (16 * c) * 65 + n; u32x4 o;
#pragma unroll
            for (int q = 0; q < 4; ++q) o[q] = cvt4_fp8(s[(4 * q) * 65] * scale, s[(4 * q + 1) * 65] * scale, s[(4 * q + 2) * 65] * scale, s[(4 * q + 3) * 65] * scale);
            st16_wt(wsbase, (unsigned)(dst0 - wsbase) + (unsigned)(n * ldk + k0 + 16 * c), o); }
        LDS_WAIT(); asm volatile("" ::: "memory"); return; }
    const int c = lane & 7;
#pragma unroll
    for (int j = 0; j < 8; ++j) { const int n = (lane >> 3) + 8 * j; const LAS float* s = scr + (8 * c) * 65 + n;
        if (FP8) { }
        else { u32x4 o; o.x = cvtpk(s[0 * 65], s[1 * 65]); o.y = cvtpk(s[2 * 65], s[3 * 65]); o.z = cvtpk(s[4 * 65], s[5 * 65]); o.w = cvtpk(s[6 * 65], s[7 * 65]);
            *(u32x4*)(dst0 + ((size_t)n * ldk + k0 + 8 * c) * 2) = o; } }
    LDS_WAIT(); asm volatile("" ::: "memory");
}

__device__ __forceinline__ void convert_weights(const Params& P, int l, LAS unsigned char* lds, int gw, int NGW, int wave, int lane, int it_first = -1, int it_stride = 0, int it_last = 0, bool do_wsb = true) {
    LAS float* scr = (LAS float*)(lds + wave * 16640);
    unsigned char* ws = P.ws;
    unsigned char* Win = ws + WS_WIN; unsigned char* Wout = ws + WS_WOUT; unsigned char* Wgu = ws + ((l & 1) ? WS_WGU1 : WS_WGU); unsigned char* Wd = ws + ((l & 1) ? WS_WD1 : WS_WD);
    constexpr int I_IN = 16 * 28, I_OUT = 16 * 16, I_E = 32 * 128;
    constexpr int NITEMS = I_IN + I_OUT + 3 * I_E;
    if (it_first < 0) { it_first = gw; it_stride = NGW; it_last = NITEMS; }
    for (int it = it_first; it < it_last; it += it_stride) {
        int r = it;
        if (r < 2 * I_E) { const int up = r / I_E; r -= up * I_E; const int e = r >> 7, q = r & 127, kb = q >> 3, nb = q & 7, n0 = nb * 64;
            const float* src = (up ? P.in[I_WUP] : P.in[I_WGATE]) + ((size_t)l * NE + e) * DM * DE;
            const int dr = 256 * (n0 >> 7) + (n0 & 127) + (up ? 128 : 0);
            transpose_item<true>(src, DE, kb * 64, n0, Wgu + ((size_t)e * 1024 + dr) * DM, DM, S_W8, scr, lane, ws); continue; }
        r -= 2 * I_E;
        if (r < I_E) { const int e = r >> 7, q = r & 127, kb = q >> 4, nb = q & 15;
            transpose_item<true>(P.in[I_WDOWN] + ((size_t)l * NE + e) * DE * DM, DM, kb * 64, nb * 64, Wd + ((size_t)e * 1024 + nb * 64) * DE, DE, S_W8, scr, lane, ws); continue; }
        r -= I_E;
        if (r < I_IN) { const int kb = r / 28, nb = r % 28, n0 = nb * 64; int dr;
            if (n0 < 1280) dr = n0; else if (n0 < 1536) { const int j = n0 - 1280; dr = 1280 + 256 * (j >> 7) + (j & 127); } else { const int j = n0 - 1536; dr = 1280 + 256 * (j >> 7) + 128 + (j & 127); }
            transpose_item<true>(P.in[I_WIN] + (size_t)l * DM * INW, INW, kb * 64, n0, Win + (size_t)dr * DM, DM, S_W8, scr, lane, ws); continue; }
        r -= I_IN;
        { const int kb = r / 16, nb = r % 16; transpose_item<true>(P.in[I_WOUT] + (size_t)l * DM * DM, DM, kb * 64, nb * 64, Wout + (size_t)(nb * 64) * DM, DM, S_W8, scr, lane, ws); }
    }
    if (!do_wsb) return;
    bf16_t* wsb = (bf16_t*)(ws + WS_WSB); const float* gws = P.in[I_GWS] + (size_t)l * 4 * 128 * 128;
    for (int i = gw * 64 + lane; i < 4 * 128 * 128 / 2; i += NGW * 64) { const f32x2 v = *(const f32x2*)(gws + 2 * i); ((unsigned*)wsb)[i] = cvtpk(v.x, v.y); }
}

__device__ __forceinline__ void phase_prep(const Params& P, LAS unsigned char* lds, int vcu, int G) {
    const int tid = phase_tid(), lane = tid & 63, wave = __builtin_amdgcn_readfirstlane(tid >> 6);
    float* mod = (float*)(P.ws + WS_MOD);
    if (vcu < 96) {
        LAS float* sc = (LAS float*)lds;
        LAS float* red = (LAS float*)(lds + 32768);
        for (int i = tid; i < 8192; i += 512) sc[i] = silu_f(P.in[I_C][i]);
        __syncthreads();
        const int l = vcu / 48, rem = vcu % 48, cc = rem >> 1, dh = rem & 1; const int col = cc * 256 + 4 * lane; const int d0 = dh * 512 + wave * 64;
        const float* w = P.in[I_ADAW] + ((size_t)l * DM + d0) * 6144 + col;
        f32x4 a[8];
#pragma unroll
        for (int bq = 0; bq < 8; ++bq) a[bq] = (f32x4){0.f, 0.f, 0.f, 0.f};
#pragma unroll 1
        for (int dq = 0; dq < 64; dq += 8) {
            f32x4 wv[8];
            const float* wq = w + (size_t)dq * 6144;
#pragma unroll
            for (int i = 0; i < 8; ++i) wv[i] = *(const f32x4*)(wq + (size_t)i * 6144);
#pragma unroll
            for (int i = 0; i < 8; ++i)
#pragma unroll
                for (int bq = 0; bq < 8; ++bq) a[bq] += wv[i] * sc[bq * 1024 + d0 + dq + i];
        }
#pragma unroll
        for (int bq = 0; bq < 8; ++bq) *(LAS f32x4*)(red + (wave * 8 + bq) * 256 + 4 * lane) = a[bq];
        __syncthreads();
        for (int o = tid; o < 8 * 256; o += 512) { const int bq = o >> 8, cl = o & 255; float sum = 0.f;
#pragma unroll
            for (int w8 = 0; w8 < 8; ++w8) sum += red[(w8 * 8 + bq) * 256 + cl];
            if (dh == 0) sum += P.in[I_ADAB][l * 6144 + cc * 256 + cl];
            atomicAdd(mod + ((size_t)l * 8 + bq) * 6144 + cc * 256 + cl, sum); }
        __syncthreads();
    }
    if (vcu == (G > 200 ? 200 : 0)) {
        float* bt = (float*)(P.ws + WS_BTAB);
        for (int i = tid; i < 8 * 260; i += 512) { const int h = i / 260, idx = i % 260; float v = 0.f;
            if (idx <= 256) { const int rel = idx - 128; const int n = rel < 0 ? -rel : rel; int bk;
                if (n < 8) bk = n; else if (n < 12) bk = 8; else if (n < 16) bk = 9; else if (n < 23) bk = 10; else if (n < 32) bk = 11; else if (n < 46) bk = 12; else if (n < 64) bk = 13; else if (n < 91) bk = 14; else bk = 15;
                if (rel > 0) bk += 16;
                v = P.in[I_RELB][bk * 8 + h] * LOG2E; }
            bt[i] = v; }
    }
    __syncthreads();
    if (G == 256) { constexpr int NIT = 16 * 28 + 16 * 16 + 3 * 32 * 128;
        if (vcu < 96) convert_weights(P, 0, lds, vcu * 8 + wave, G * 8, wave, lane, 4096 + vcu * 8 + wave, 96 * 8, 4096 + 768, false);
        else { convert_weights(P, 0, lds, vcu * 8 + wave, G * 8, wave, lane, 4096 + 768 + (vcu - 96) * 8 + wave, 160 * 8, 8192, false);
               convert_weights(P, 0, lds, vcu * 8 + wave, G * 8, wave, lane, 12288 + (vcu - 96) * 8 + wave, 160 * 8, NIT, false); }
        convert_weights(P, 0, lds, vcu * 8 + wave, G * 8, wave, lane, 0, 1, 0, true); }
    else convert_weights(P, 0, lds, vcu * 8 + wave, G * 8, wave, lane);
}

__device__ __forceinline__ void phase_h0(const Params& P, int vcu, int G) {
    const int tid = phase_tid(), lane = tid & 63, wave = tid >> 6;
    const float* mod = (const float*)(P.ws + WS_MOD); unsigned char* H = P.ws + WS_H;
#ifdef FP8_SELFCHECK
    if (vcu == 0 && tid == 0) { const float big = 1000.f + 0.f * mod[0]; const unsigned tv = cvt4_fp8(big, -big, 460.f, 448.f);
        if (tv != 0x7E7EFE7Eu) ((float*)(P.ws + WS_MOD))[2048] = __builtin_nanf(""); }
#endif
#pragma unroll 1
    for (int ch = vcu * 8 + wave; ch * 16 < NT; ch += G * 8) {
        const int mb = ch * 16, b = mb >> 12; const float* sh = mod + (size_t)b * 6144;
        f32x4 psc[4], psh[4];
#pragma unroll
        for (int j = 0; j < 4; ++j) { const int c = RCOL(lane, j); psc[j] = *(const f32x4*)(sh + 1024 + c) + 1.0f; psh[j] = *(const f32x4*)(sh + c); }
#pragma unroll 1
        for (int q = 0; q < 2; ++q) {
            f32x4 x[8][4];
#pragma unroll
            for (int i = 0; i < 8; ++i)
#pragma unroll
                for (int j = 0; j < 4; ++j) x[i][j] = *(const f32x4*)(P.in[I_X] + (size_t)(mb + 8 * q + i) * DM + RCOL(lane, j));
#pragma unroll
            for (int i = 0; i < 8; ++i) { u32x4 hw;
#pragma unroll
                for (int j = 0; j < 4; ++j) { const f32x4 h = (x[i][j] * psc[j] + psh[j]) * S_H8; hw[j] = cvt4_fp8(h[0], h[1], h[2], h[3]); }
                st16_wt(H, (unsigned)((mb + 8 * q + i) * DM + 16 * lane), hw); }
        }
    }
}

__device__ __forceinline__ int crow(int r, int hi) { return (r & 3) + 8 * (r >> 2) + 4 * hi; }
__device__ __forceinline__ s16x4 tr_read(const LAS unsigned char* p) { return __builtin_bit_cast(s16x4, __builtin_amdgcn_ds_read_tr16_b64_v4i16((LAS v4i16_t*)p)); }

constexpr int AT_KS = 144, AT_VS = 128, AT_KOFF = 0, AT_VOFF = 384 * AT_KS, AT_BOFF = AT_VOFF + 384 * AT_VS, AT_TS = 320;
static_assert(384 * 144 + 384 * 128 + 8 * 4 * 320 * 4 <= LDS_MISC, "attention LDS map must stay below the barrier words");
constexpr float AT_THR = 8.0f;
struct KVRegs { u32x4 k[6], v[6]; };
template <bool DO_K, bool DO_V>
__device__ __forceinline__ void attn_kv_load(const bf16_t* Z, int b, int n, int kvh, int, KVRegs& r) {
    const int tid = phase_tid();
    const long tok0 = (long)b * SEQ + (long)(n - 1) * 128;
#pragma unroll
    for (int i = 0; i < 6; ++i) { const int c = tid + 512 * i, row = c >> 3, ch = c & 7, blk = n - 1 + (row >> 7);
        if (DO_K) r.k[i] = (u32x4){0u, 0u, 0u, 0u}; if (DO_V) r.v[i] = (u32x4){0u, 0u, 0u, 0u};
        if (blk >= 0 && blk < 32) { const bf16_t* src = Z + (size_t)(tok0 + row) * ZW + 1024 + kvh * 64 + ch * 8; if (DO_K) r.k[i] = *(const u32x4*)src; if (DO_V) r.v[i] = *(const u32x4*)(src + 128); } }
}
__device__ __forceinline__ void attn_kv_store(LAS unsigned char* lds, int, const KVRegs& r) {
    const int tid = phase_tid();
#pragma unroll
    for (int i = 0; i < 6; ++i) { const int c = tid + 512 * i, row = c >> 3, ch = c & 7;
        *(LAS u32x4*)(lds + AT_KOFF + row * AT_KS + ch * 16) = r.k[i]; *(LAS u32x4*)(lds + AT_VOFF + row * AT_VS + ch * 16) = r.v[i]; }
}
__device__ __forceinline__ void attn_tables(const float* btab, int tid, LAS unsigned char* lds) {
    LAS float* bt = (LAS float*)(lds + AT_BOFF);
    for (int i = tid; i < 8 * 4 * AT_TS; i += 512) { const int h8 = i / (4 * AT_TS), rem = i % (4 * AT_TS), sft = rem / AT_TS, j = rem % AT_TS; const int idx = j + sft - 32;
        bt[i] = (idx >= 0 && idx <= 256) ? btab[h8 * 260 + idx] : -1.0e30f; }
}
template <class F>
__device__ __forceinline__ void attn_compute(const bf16_t* Z, unsigned char* Y, const float* sink, int b, int n, int kvh, LAS unsigned char* lds, F&& prefetch) {
    const int tid = phase_tid(), lane = tid & 63, wid = __builtin_amdgcn_readfirstlane(tid >> 6), r32 = lane & 31, hi = lane >> 5;
    const int hh = wid >> 1, qh = wid & 1, head = kvh * 4 + hh;
    const LAS float* bt = (const LAS float*)(lds + AT_BOFF);
    const float sk = sink[head] * LOG2E;
#pragma unroll 1
    for (int rb = 0; rb < 2; ++rb) {
        const int qb = 2 * qh + rb; const int iq = 32 * qb + r32;
        const size_t qtok = (size_t)b * SEQ + (size_t)n * 128 + iq;
        bf16x8 qf[4];
#pragma unroll
        for (int ks = 0; ks < 4; ++ks) qf[ks] = *(const bf16x8*)(Z + qtok * ZW + 512 + head * 64 + 16 * ks + 8 * hi);
        if (rb == 0) prefetch();
        float mrun = sk, lrun = hi ? 0.f : 1.0f; f32x16 o0 = {}, o1 = {};
#pragma unroll 1
        for (int kb = 0; kb < 3; ++kb) {
            const int blk = n - 1 + kb; if (blk < 0 || blk >= 32) continue;
            const int kt_lo = (kb == 0) ? qb : 0, kt_hi = (kb == 2) ? qb : 3;
#define AT_QK(P_, KROW_) do { const int i0_ = (KROW_) - iq + 4 * hi + 32; const int sft_ = i0_ & 3; const LAS float* bp_ = bt + (head * 4 + sft_) * AT_TS + (i0_ - sft_); \
                _Pragma("unroll") for (int g4 = 0; g4 < 4; ++g4) { const f32x4 bv = *(const LAS f32x4*)(bp_ + 8 * g4); _Pragma("unroll") for (int t = 0; t < 4; ++t) P_[4 * g4 + t] = bv[t] - mrun; } \
                _Pragma("unroll") for (int ks = 0; ks < 4; ++ks) { const bf16x8 kf = *(const LAS bf16x8*)(lds + AT_KOFF + ((KROW_) + r32) * AT_KS + (16 * ks + 8 * hi) * 2); \
                    P_ = __builtin_amdgcn_mfma_f32_32x32x16_bf16(kf, qf[ks], P_, 0, 0, 0); } } while (0)
#define AT_EXP(P_, RS_) do { RS_ = 0.f; _Pragma("unroll") for (int r = 0; r < 16; ++r) { const float e = fast_exp2(P_[r]); P_[r] = e; RS_ += e; } } while (0)
#define AT_PV(P_, KROW_) do { u32x4 pw0, pw1; \
                pw0.x = cvtpk(P_[0], P_[1]); pw0.y = cvtpk(P_[2], P_[3]); pw0.z = cvtpk(P_[4], P_[5]); pw0.w = cvtpk(P_[6], P_[7]); \
                pw1.x = cvtpk(P_[8], P_[9]); pw1.y = cvtpk(P_[10], P_[11]); pw1.z = cvtpk(P_[12], P_[13]); pw1.w = cvtpk(P_[14], P_[15]); \
                const LAS unsigned char* vb = lds + AT_VOFF + ((KROW_) + 4 * hi + ((lane & 15) >> 2)) * AT_VS + (16 * ((lane >> 4) & 1) + 4 * (lane & 3)) * 2; \
                _Pragma("unroll") for (int s2 = 0; s2 < 2; ++s2) { const bf16x8 pf = __builtin_bit_cast(bf16x8, s2 == 0 ? pw0 : pw1); \
                    _Pragma("unroll") for (int db = 0; db < 2; ++db) { \
                        const s16x4 lo = tr_read(vb + (16 * s2) * AT_VS + db * 64), hv = tr_read(vb + (16 * s2 + 8) * AT_VS + db * 64); \
                        const bf16x8 vf = {lo[0], lo[1], lo[2], lo[3], hv[0], hv[1], hv[2], hv[3]}; \
                        if (db == 0) o0 = __builtin_amdgcn_mfma_f32_32x32x16_bf16(vf, pf, o0, 0, 0, 0); else o1 = __builtin_amdgcn_mfma_f32_32x32x16_bf16(vf, pf, o1, 0, 0, 0); } } } while (0)
#define AT_CAREFUL(P_, KROW_) do { AT_QK(P_, KROW_); \
                float mx = fmaxf(fmaxf(P_[0], P_[1]), fmaxf(P_[2], P_[3])); \
                _Pragma("unroll") for (int r = 4; r < 16; r += 4) mx = fmaxf(mx, fmaxf(fmaxf(P_[r], P_[r + 1]), fmaxf(P_[r + 2], P_[r + 3]))); \
                mx = max_halves(mx); const float d = fmaxf(mx, 0.f), f = fast_exp2(-d); mrun += d; lrun *= f; float rs_ = 0.f; \
                _Pragma("unroll") for (int r = 0; r < 16; ++r) { const float e = fast_exp2(P_[r] - d); P_[r] = e; rs_ += e; o0[r] *= f; o1[r] *= f; } \
                lrun += rs_; AT_PV(P_, KROW_); } while (0)
            int kt = kt_lo;
#pragma unroll 1
            for (; kt + 1 <= kt_hi; kt += 2) {
                const int krow = kb * 128 + kt * 32;
                f32x16 pa, pb; float rsa, rsb;
                AT_QK(pa, krow); AT_QK(pb, krow + 32);
                AT_EXP(pa, rsa); AT_EXP(pb, rsb);
                if (__any(!(rsa + rsb < 65536.0f))) { AT_CAREFUL(pa, krow); AT_CAREFUL(pb, krow + 32); }
                else { lrun += rsa + rsb; AT_PV(pa, krow); AT_PV(pb, krow + 32); }
            }
            if (kt <= kt_hi) {
                const int krow = kb * 128 + kt * 32;
                f32x16 pa; float rsa;
                AT_QK(pa, krow); AT_EXP(pa, rsa);
                if (__any(!(rsa < 65536.0f))) { AT_CAREFUL(pa, krow); }
                else { lrun += rsa; AT_PV(pa, krow); }
            }
#undef AT_QK
#undef AT_EXP
#undef AT_PV
#undef AT_CAREFUL
        }
        lrun = sum_halves(lrun);
        const float inv = 1.0f / lrun;
        unsigned char* yo = Y + qtok * DM + 256 + head * 64; const float inv8 = inv * S_YC8;
#pragma unroll
        for (int g4 = 0; g4 < 4; ++g4) {
            *(unsigned*)(yo + 8 * g4 + 4 * hi) = cvt4_fp8(o0[4 * g4] * inv8, o0[4 * g4 + 1] * inv8, o0[4 * g4 + 2] * inv8, o0[4 * g4 + 3] * inv8);
            *(unsigned*)(yo + 32 + 8 * g4 + 4 * hi) = cvt4_fp8(o1[4 * g4] * inv8, o1[4 * g4 + 1] * inv8, o1[4 * g4 + 2] * inv8, o1[4 * g4 + 3] * inv8); }
    }
}

constexpr int GM_VS = 544;
struct GmRegs { u32x2 v[16]; bf16x8 wf[4][4]; };
__device__ __forceinline__ void gm_load(const bf16_t* Z, size_t tokbase, int, int, GmRegs& r) {
    const int tid = phase_tid(), lane = tid & 63, wid = tid >> 6;
#pragma unroll
    for (int i = 0; i < 16; ++i) r.v[i] = *(const u32x2*)(Z + (tokbase + wid * 16 + i) * ZW + 256 + 4 * lane);
}
__device__ __forceinline__ void gm_load_ws(const Params& P, int, int, GmRegs& r) {
    const int tid = phase_tid(), lane = tid & 63, wid = tid >> 6;
    const int hh = wid >> 1, ph = wid & 1, fr = lane & 15, fq = lane >> 4;
    const bf16_t* wsb = (const bf16_t*)(P.ws + WS_WSB) + (size_t)hh * 128 * 128;
#pragma unroll
    for (int ks = 0; ks < 4; ++ks)
#pragma unroll
        for (int pt = 0; pt < 4; ++pt) r.wf[ks][pt] = *(const bf16x8*)(wsb + (size_t)(ph * 64 + pt * 16 + fr) * 128 + ks * 32 + 8 * fq);
}
__device__ __forceinline__ void gm_ln_store(const Params& P, int l, int, int, const GmRegs& r, LAS unsigned char* lds) {
    const int tid = phase_tid(), lane = tid & 63, wid = tid >> 6;
    const f32x4 g = *(const f32x4*)(P.in[I_GLNG] + l * 256 + 4 * lane), be = *(const f32x4*)(P.in[I_GLNB] + l * 256 + 4 * lane);
#pragma unroll
    for (int i = 0; i < 16; ++i) { const int t = wid * 16 + i; const u32x2 w = r.v[i];
        f32x4 v = {bf_lo(w.x), bf_hi(w.x), bf_lo(w.y), bf_hi(w.y)};
        const float mean = wave_sum((v[0] + v[1]) + (v[2] + v[3])) * (1.f / 256.f); v = v - mean;
        const float var = wave_sum((v[0] * v[0] + v[1] * v[1]) + (v[2] * v[2] + v[3] * v[3])) * (1.f / 256.f);
        const float rstd = __builtin_amdgcn_rsqf(var + LN_EPS); v = v * rstd * g + be;
        u32x2 o; o.x = cvtpk(v[0], v[1]); o.y = cvtpk(v[2], v[3]); *(LAS u32x2*)(lds + t * GM_VS + 8 * lane) = o; }
}
__device__ __forceinline__ void gm_mfma(const Params& P, int l, const bf16_t* Z, unsigned char* Y, size_t tokbase, int, int, const GmRegs& r, LAS unsigned char* lds) {
    const int tid = phase_tid(), lane = tid & 63, wid = tid >> 6;
    const int hh = wid >> 1, ph = wid & 1, fr = lane & 15, fq = lane >> 4;
    u32x2 uw[4][4];
#pragma unroll
    for (int pt = 0; pt < 4; ++pt)
#pragma unroll
        for (int dt = 0; dt < 4; ++dt) uw[pt][dt] = *(const u32x2*)(Z + (tokbase + ph * 64 + pt * 16 + fr) * ZW + hh * 64 + 16 * dt + 4 * fq);
    f32x4 acc[4][4];
#pragma unroll
    for (int dt = 0; dt < 4; ++dt)
#pragma unroll
        for (int pt = 0; pt < 4; ++pt) acc[dt][pt] = (f32x4){0.f, 0.f, 0.f, 0.f};
#pragma unroll
    for (int ks = 0; ks < 4; ++ks) {
        const LAS unsigned char* vb = lds + (ks * 32 + 8 * fq + (fr >> 2)) * GM_VS + (hh * 64 + 4 * (fr & 3)) * 2;
#pragma unroll
        for (int dt = 0; dt < 4; ++dt) { const s16x4 lo = tr_read(vb + dt * 32), hv = tr_read(vb + 4 * GM_VS + dt * 32);
            const bf16x8 vf = {lo[0], lo[1], lo[2], lo[3], hv[0], hv[1], hv[2], hv[3]};
#pragma unroll
            for (int pt = 0; pt < 4; ++pt) acc[dt][pt] = __builtin_amdgcn_mfma_f32_16x16x32_bf16(vf, r.wf[ks][pt], acc[dt][pt], 0, 0, 0); }
    }
    const float* bs = P.in[I_GBS] + l * 512 + hh * 128;
#pragma unroll
    for (int pt = 0; pt < 4; ++pt) { const int p = ph * 64 + pt * 16 + fr; const float bsv = bs[p];
#pragma unroll
        for (int dt = 0; dt < 4; ++dt) { const int c = hh * 64 + 16 * dt + 4 * fq; const u32x2 u2 = uw[pt][dt];
            const f32x4 a = (acc[dt][pt] + bsv) * S_YC8;
            *(unsigned*)(Y + (tokbase + p) * DM + c) = cvt4_fp8(bf_lo(u2.x) * a[0], bf_hi(u2.x) * a[1], bf_lo(u2.y) * a[2], bf_hi(u2.y) * a[3]); } }
}
struct CvRegs { u32x4 c[6]; };
__device__ __forceinline__ void cv_load(const bf16_t* Z, int b, int n, int hf, int, CvRegs& r) {
    const int tid = phase_tid();
    const int s0 = n * 128 + hf * 64;
#pragma unroll
    for (int i = 0; i < 6; ++i) { const int c = tid + 512 * i, row = c >> 5, ch = c & 31; const int sq = s0 - 15 + row; r.c[i] = (u32x4){0u, 0u, 0u, 0u};
        if (row < 94 && sq >= 0 && sq < SEQ) r.c[i] = *(const u32x4*)(Z + ((size_t)b * SEQ + sq) * ZW + 1280 + ch * 8); }
}
__device__ __forceinline__ void cv_store(LAS unsigned char* lds, int, const CvRegs& r) {
    const int tid = phase_tid();
#pragma unroll
    for (int i = 0; i < 6; ++i) { const int c = tid + 512 * i, row = c >> 5, ch = c & 31; const u32x4 v = r.c[i];
        if (row < 94) { *(LAS f32x4*)(lds + row * 1024 + ch * 32) = (f32x4){bf_lo(v.x), bf_hi(v.x), bf_lo(v.y), bf_hi(v.y)};
            *(LAS f32x4*)(lds + row * 1024 + ch * 32 + 16) = (f32x4){bf_lo(v.z), bf_hi(v.z), bf_lo(v.w), bf_hi(v.w)}; } }
}
__device__ __forceinline__ void cv_compute(const f32x4 (&cw)[31], f32x4 cb, f32x4 g, f32x4 be, unsigned char* Y, size_t tok0, int, int, LAS unsigned char* lds) {
    const int tid = phase_tid(), lane = tid & 63, wid = tid >> 6;
#pragma unroll 1
    for (int pr = 0; pr < 4; ++pr) { const int t = wid * 8 + 2 * pr; f32x4 a0 = cb, a1 = cb;
        const LAS unsigned char* yp = lds + t * 1024 + 16 * lane;
        f32x4 yq[8];
#pragma unroll
        for (int r = 0; r < 8; ++r) yq[r] = *(const LAS f32x4*)(yp + r * 1024);
        __builtin_amdgcn_sched_barrier(0);
#pragma unroll
        for (int r4 = 0; r4 < 32; r4 += 4) {
            f32x4 yc[4];
#pragma unroll
            for (int k = 0; k < 4; ++k) yc[k] = yq[(r4 + k) & 7];
#pragma unroll
            for (int k = 0; k < 4; ++k) if (r4 + k + 8 < 32) yq[(r4 + k) & 7] = *(const LAS f32x4*)(yp + (r4 + k + 8) * 1024);
#pragma unroll
            for (int k = 0; k < 4; ++k) { const int r = r4 + k;
                if (r < 31) a0 += yc[k] * cw[r];
                if (r > 0) a1 += yc[k] * cw[r - 1]; }
            __builtin_amdgcn_sched_barrier(0);
        }
#pragma unroll
        for (int i = 0; i < 2; ++i) { f32x4 a = i ? a1 : a0;
            const float mean = wave_sum((a[0] + a[1]) + (a[2] + a[3])) * (1.f / 256.f); a = a - mean;
            const float var = wave_sum((a[0] * a[0] + a[1] * a[1]) + (a[2] * a[2] + a[3] * a[3])) * (1.f / 256.f);
            const float rstd = __builtin_amdgcn_rsqf(var + LN_EPS); a = a * rstd * g + be;
            *(unsigned*)(Y + (tok0 + t + i) * DM + 768 + 4 * lane) = cvt4_fp8(silu_f(a[0]) * S_YC8, silu_f(a[1]) * S_YC8, silu_f(a[2]) * S_YC8, silu_f(a[3]) * S_YC8); } }
}

__device__ __forceinline__ void phase_mixers(const Params& P, int l, LAS unsigned char* lds, int vcu, int G) {
    const bf16_t* Z = (const bf16_t*)(P.ws + WS_Z); unsigned char* Y = P.ws + WS_YCAT;
    const float* sink = P.in[I_SINK] + l * 8;
    const int tid = phase_tid(), lane = tid & 63, wid = __builtin_amdgcn_readfirstlane(tid >> 6);
    bool tables_done = false;
#pragma unroll 1
    for (int u = vcu; u < NB * 32; u += G) { const int b = u >> 5, n = u & 31; const size_t tokbase = (size_t)b * SEQ + (size_t)n * 128;
        {
        { KVRegs kv; attn_kv_load<true, true>(Z, b, n, 0, tid, kv);
          if (!tables_done) { attn_tables((const float*)(P.ws + WS_BTAB), tid, lds); tables_done = true; }
          attn_kv_store(lds, tid, kv); }
        __syncthreads();
        { attn_compute(Z, Y, sink, b, n, 0, lds, [&]() {});
          KVRegs kv; attn_kv_load<true, true>(Z, b, n, 1, tid, kv);
          __syncthreads();
          attn_kv_store(lds, tid, kv); }
        __syncthreads();
        }
        attn_compute(Z, Y, sink, b, n, 1, lds, [&]() {});
        GmRegs gm; gm_load(Z, tokbase, wid, lane, gm);
        __syncthreads();
        {
        gm_load_ws(P, wid, lane, gm);
        gm_ln_store(P, l, wid, lane, gm, lds);
        CvRegs cv; cv_load(Z, b, n, 0, tid, cv);
        __syncthreads();
        gm_mfma(P, l, Z, Y, tokbase, wid, lane, gm, lds);
        __syncthreads();
        cv_store(lds, tid, cv);
        f32x4 cw[31]; f32x4 cb, g, be;
        { const int lane2 = phase_tid() & 63; const float* cwp = P.in[I_CONVW] + (size_t)l * 31 * 256 + 4 * lane2;
#pragma unroll
          for (int w = 0; w < 31; ++w) cw[w] = *(const f32x4*)(cwp + w * 256);
          cb = *(const f32x4*)(P.in[I_CONVB] + l * 256 + 4 * lane2); g = *(const f32x4*)(P.in[I_CLNG] + l * 256 + 4 * lane2); be = *(const f32x4*)(P.in[I_CLNB] + l * 256 + 4 * lane2); }
        cv_load(Z, b, n, 1, tid, cv);
        __syncthreads();
        cv_compute(cw, cb, g, be, Y, tokbase, wid, lane, lds);
        __syncthreads();
        cv_store(lds, tid, cv);
        __syncthreads();
        cv_compute(cw, cb, g, be, Y, tokbase + 64, wid, lane, lds);
        __syncthreads();
        }
    }
}

__device__ __forceinline__ void moe_table(const Params& P, int l, LAS unsigned char* lds, int vcu) {
    LAS int* ts = (LAS int*)(lds + LDS_TS); LAS int* cn = (LAS int*)(lds + LDS_TS + 256); LAS int* ue = (LAS int*)(lds + LDS_TS + 384);
    const int tidm = phase_tid();
    if (tidm < 64) { const int lane = tidm; unsigned* cw = (unsigned*)(P.ws + WS_CTL) + CW_CNT + 2048 * l;
        const int c = lane < NE ? (int)__hip_atomic_load(cw + 64 * lane, __ATOMIC_RELAXED, __HIP_MEMORY_SCOPE_AGENT) : 0;
        const int nt = (c + 255) >> 8; int incl = nt;
#pragma unroll
        for (int o = 1; o < 32; o <<= 1) { const int v = __builtin_amdgcn_ds_bpermute(((lane - o) & 63) << 2, incl); if ((lane & 31) >= o) incl += v; }
        if (lane < NE) { ts[lane] = incl - nt; cn[lane] = c; }
        if (lane == NE - 1) ts[NE] = incl; }
    __syncthreads();
    { const int lane = tidm & 63, i = tidm >> 6;
      const int tile = (i * 256 + vcu) >> 2; const bool le = lane >= 1 && lane < NE && ts[lane] <= tile;
      const unsigned long long mk = __ballot(le);
      if (lane == 0) ue[i] = tile < ts[NE] ? __popcll(mk) : -1; }
    __syncthreads();
}

constexpr int LA_RS = 2064;
constexpr int LA_HI = 0, LA_PART = 32 * LA_RS, LA_HIST = LA_PART + 8 * 32 * 32 * 4, LA_BASE = LA_HIST + 128, LA_REC = LA_HIST + 256;
__device__ __forceinline__ void phase_ln_a(const Params& P, int l, LAS unsigned char* lds, int vcu, int G, bool dry = false) {
    const int tid = phase_tid(), lane = tid & 63, wave = __builtin_amdgcn_readfirstlane(tid >> 6), r32 = lane & 31, hi = lane >> 5;
    LAS int* hist = (LAS int*)(lds + LA_HIST); LAS int* basel = (LAS int*)(lds + LA_BASE); LAS int* rec = (LAS int*)(lds + LA_REC);
    LAS float* part = (LAS float*)(lds + LA_PART);
    if (tid < 32) hist[tid] = 0;
    bf16x8 bhi[8], blo[8];
    { const float* rw = P.in[I_RW];
#pragma unroll
      for (int ks = 0; ks < 8; ++ks) { u32x4 hw, lw;
#pragma unroll
          for (int jp = 0; jp < 4; ++jp) { const int k = 128 * wave + 16 * ks + 8 * hi + 2 * jp; const float w0 = rw[(size_t)k * 32 + r32], w1 = rw[(size_t)(k + 1) * 32 + r32];
              const unsigned h = cvtpk(w0, w1); const unsigned lo = cvtpk(w0 - bf_lo(h), w1 - bf_hi(h)); hw[jp] = h; lw[jp] = lo; }
          bhi[ks] = __builtin_bit_cast(bf16x8, hw); blo[ks] = __builtin_bit_cast(bf16x8, lw); } }
    const bf16_t* R = (const bf16_t*)(P.ws + WS_R); unsigned char* H8 = P.ws + WS_H8;
    const float* mod = (const float*)(P.ws + WS_MOD) + (size_t)l * 8 * 6144;
    const float* lg = P.in[I_LMG] + l * DM; const float* lb = P.in[I_LMB] + l * DM;
    unsigned* cntw = (unsigned*)(P.ws + WS_CTL) + CW_CNT + 2048 * (dry ? 2 + l : l);
    int* list = (int*)(P.ws + WS_LIST); int* rinfo = (int*)(P.ws + WS_RINFO); float* rgate = (float*)(P.ws + WS_RGATE);
    const float rbias = P.in[I_RB][lane & 31];
    __syncthreads();
#pragma unroll 1
    for (int blk = vcu; blk * 128 < NT; blk += G) {
        const int mb = blk * 128;
        f32x4 plg[4], plb[4], psc[4], psh[4];
        { const int bb = mb >> 12; const float* shb = mod + (size_t)bb * 6144 + 3072;
#pragma unroll
          for (int j = 0; j < 4; ++j) { const int c = RCOL(lane, j); plg[j] = *(const f32x4*)(lg + c); plb[j] = *(const f32x4*)(lb + c); psc[j] = *(const f32x4*)(shb + 1024 + c) + 1.0f; psh[j] = *(const f32x4*)(shb + c); } }
        u32x4 vn[4][2];
#pragma unroll
        for (int i = 0; i < 4; ++i)
#pragma unroll
            for (int j = 0; j < 2; ++j) vn[i][j] = *(const u32x4*)(R + (size_t)(mb + 4 * wave + i) * DM + 16 * lane + 8 * j);
#pragma unroll 1
        for (int rd = 0; rd < 4; ++rd) {
#pragma unroll
            for (int ip = 0; ip < 2; ++ip) {
                f32x4 v[2][4];
#pragma unroll
                for (int i = 0; i < 2; ++i)
#pragma unroll
                    for (int j = 0; j < 4; ++j) { const u32x4 w4 = vn[2 * ip + i][j >> 1]; const unsigned wx_ = w4[2 * (j & 1)], wy_ = w4[2 * (j & 1) + 1]; v[i][j] = (f32x4){bf_lo(wx_), bf_hi(wx_), bf_lo(wy_), bf_hi(wy_)}; }
                if (rd < 3) {
#pragma unroll
                    for (int i = 0; i < 2; ++i)
#pragma unroll
                        for (int j = 0; j < 2; ++j) vn[2 * ip + i][j] = *(const u32x4*)(R + (size_t)(mb + 32 * (rd + 1) + 4 * wave + 2 * ip + i) * DM + 16 * lane + 8 * j);
                }
#pragma unroll
                for (int i = 0; i < 2; ++i) {
                    const int lr = 4 * wave + 2 * ip + i; const int m = mb + 32 * rd + lr;
                    float s = 0.f;
#pragma unroll
                    for (int j = 0; j < 4; ++j) s += (v[i][j][0] + v[i][j][1]) + (v[i][j][2] + v[i][j][3]);
                    const float mean = wave_sum(s) * (1.f / DM); float s2 = 0.f;
#pragma unroll
                    for (int j = 0; j < 4; ++j) { v[i][j] = v[i][j] - mean; s2 += (v[i][j][0] * v[i][j][0] + v[i][j][1] * v[i][j][1]) + (v[i][j][2] * v[i][j][2] + v[i][j][3] * v[i][j][3]); }
                    const float rstd = __builtin_amdgcn_rsqf(wave_sum(s2) * (1.f / DM) + LN_EPS);
                    u32x4 wha, whb, h8;
#pragma unroll
                    for (int j = 0; j < 4; ++j) { const f32x4 x1 = v[i][j] * rstd * plg[j] + plb[j];
                        const f32x4 h = x1 * psc[j] + psh[j];
                        const unsigned h_lo = cvtpk(h[0], h[1]), h_hi = cvtpk(h[2], h[3]);
                        if (j < 2) { wha[2 * j] = h_lo; wha[2 * j + 1] = h_hi; } else { whb[2 * j - 4] = h_lo; whb[2 * j - 3] = h_hi; }
                        h8[j] = cvt4_fp8(h[0] * S_H8, h[1] * S_H8, h[2] * S_H8, h[3] * S_H8); }
                    st16_wt(H8, (unsigned)(m * DM + 16 * lane), h8);
                    *(LAS u32x4*)(lds + LA_HI + lr * LA_RS + 32 * lane) = wha; *(LAS u32x4*)(lds + LA_HI + lr * LA_RS + 32 * lane + 16) = whb;
                }
            }
            __syncthreads();
            { f32x16 acc = {};
#pragma unroll
              for (int ks = 0; ks < 8; ++ks) { const bf16x8 ah = *(const LAS bf16x8*)(lds + LA_HI + r32 * LA_RS + (128 * wave + 16 * ks + 8 * hi) * 2);
                  acc = __builtin_amdgcn_mfma_f32_32x32x16_bf16(ah, bhi[ks], acc, 0, 0, 0); acc = __builtin_amdgcn_mfma_f32_32x32x16_bf16(ah, blo[ks], acc, 0, 0, 0); }
#pragma unroll
              for (int r = 0; r < 16; ++r) part[(wave * 32 + crow(r, hi)) * 32 + r32] = acc[r]; }
            __syncthreads();
#pragma unroll
            for (int ps = 0; ps < 2; ++ps) {
                const int lr = 4 * wave + 2 * ps + hi; const int m = mb + 32 * rd + lr; const int e = lane & 31;
                float logit = 0.f;
#pragma unroll
                for (int w8 = 0; w8 < 8; ++w8) logit += part[(w8 * 32 + lr) * 32 + e];
                const float score = 1.0f / (1.0f + __expf(-logit)); const float sel = score + rbias;
                int rank = 0;
#define RANK_STEP(J) { const float o = xlane_f<J>(sel, lane); const int oe = e ^ J; rank += (o > sel || (o == sel && oe < e)) ? 1 : 0; }
                RANK_STEP(1) RANK_STEP(2) RANK_STEP(3) RANK_STEP(4) RANK_STEP(5) RANK_STEP(6) RANK_STEP(7)
#undef RANK_STEP
                float gs = rank < 2 ? sel : 0.f; gs += xlane_f<1>(gs, lane); gs += xlane_f<2>(gs, lane); gs += xlane_f<7>(gs, lane);
                float bgs = gs; int bg = e >> 3;
                { const float ogs = xlane_f<8>(bgs, lane); const int og = xlane_i<8>(bg, lane); if (ogs > bgs || (ogs == bgs && og < bg)) { bgs = ogs; bg = og; } }
                { const float ogs = xlane_f<16>(bgs, lane); const int og = xlane_i<16>(bg, lane); if (ogs > bgs || (ogs == bgs && og < bg)) { bgs = ogs; bg = og; } }
                const unsigned long long mk0 = __ballot((e >> 3) == bg && rank == 0), mk1 = __ballot((e >> 3) == bg && rank == 1);
                const unsigned h0m = hi ? (unsigned)(mk0 >> 32) : (unsigned)mk0, h1m = hi ? (unsigned)(mk1 >> 32) : (unsigned)mk1;
                const int e0 = __ffs(h0m) - 1, e1 = __ffs(h1m) - 1;
                const float sc0 = __shfl(score, 32 * hi + e0), sc1 = __shfl(score, 32 * hi + e1);
                if (e == 0) { const float inv = 1.0f / (sc0 + sc1);
                    const int q0 = __hip_atomic_fetch_add(hist + e0, 1, __ATOMIC_RELAXED, __HIP_MEMORY_SCOPE_WORKGROUP);
                    const int q1 = __hip_atomic_fetch_add(hist + e1, 1, __ATOMIC_RELAXED, __HIP_MEMORY_SCOPE_WORKGROUP);
                    LAS int* rp = rec + (32 * rd + lr) * 4; rp[0] = e0; rp[1] = q0; rp[2] = e1; rp[3] = q1;
                    if (!dry) { rgate[2 * m] = sc0 * inv; rgate[2 * m + 1] = sc1 * inv; } }
            }
        }
        __syncthreads();
        if (tid < 32) { const int c = hist[tid]; basel[tid] = c ? (int)__hip_atomic_fetch_add(cntw + 64 * tid, (unsigned)c, __ATOMIC_RELAXED, __HIP_MEMORY_SCOPE_AGENT) : 0; hist[tid] = 0; }
        __syncthreads();
        if (tid < 128 && !dry) { const int m = mb + tid; const LAS int* rp = rec + tid * 4; const int e0 = rp[0], p0 = basel[e0] + rp[1], e1 = rp[2], p1 = basel[e1] + rp[3];
            list[(size_t)e0 * 65536 + p0] = m; list[(size_t)e1 * 65536 + p1] = m;
            *(int4*)(rinfo + 4 * m) = make_int4(e0, p0, e1, p1); }
        __syncthreads();
    }
}

__device__ __forceinline__ void phase_ln_b(const Params& P, int l, LAS unsigned char* lds, int vcu, int G) {
    const int tid = phase_tid(), lane = tid & 63, wave = tid >> 6;
    if (!MK_ONE_LAUNCH) moe_table(P, l, lds, vcu);
    const LAS int* ts = (const LAS int*)(lds + LDS_TS);
    const bf16_t* X1 = (const bf16_t*)(P.ws + WS_R); const unsigned char* YE = P.ws + WS_YE; unsigned char* H = P.ws + WS_H; bf16_t* XB = (bf16_t*)(P.ws + WS_XB);
    const float* lmg = P.in[I_LMG] + l * DM; const float* lmb = P.in[I_LMB] + l * DM;
    const float* mod = (const float*)(P.ws + WS_MOD) + (size_t)l * 8 * 6144; const float* modn = (const float*)(P.ws + WS_MOD) + (size_t)(l + 1) * 8 * 6144;
    const float* lg = P.in[I_LFG] + l * DM; const float* lb = P.in[I_LFB] + l * DM;
    const int* rinfo = (const int*)(P.ws + WS_RINFO); const float* rgate = (const float*)(P.ws + WS_RGATE);
#pragma unroll 1
    for (int ch = vcu * 8 + wave; ch * 16 < NT; ch += G * 8) {
        const int mb = ch * 16;
        f32x4 pg2[4], plg[4], plb[4], psc[4], psh[4], gmA[4], bmA[4];
        { const int bb = mb >> 12;
#pragma unroll
          for (int j = 0; j < 4; ++j) { const int c = RCOL(lane, j); pg2[j] = *(const f32x4*)(mod + (size_t)bb * 6144 + 5120 + c) + 1.0f; plg[j] = *(const f32x4*)(lg + c); plb[j] = *(const f32x4*)(lb + c);
              gmA[j] = *(const f32x4*)(lmg + c) * ALPHA; bmA[j] = *(const f32x4*)(lmb + c) * ALPHA;
              if (l + 1 < NL) { psc[j] = *(const f32x4*)(modn + (size_t)bb * 6144 + 1024 + c) + 1.0f; psh[j] = *(const f32x4*)(modn + (size_t)bb * 6144 + c); } else { psc[j] = plg[j]; psh[j] = plb[j]; } } }
        int sA = 0, sB = 0; float gA = 0.f, gB = 0.f;
        if (lane < 16) { const int4 ri = *(const int4*)(rinfo + 4 * (mb + lane)); const f32x2 rg = *(const f32x2*)(rgate + 2 * (mb + lane));
            sA = ts[ri.x] * 256 + ri.y; sB = ts[ri.z] * 256 + ri.w; gA = rg.x * (1.0f / S_Y8); gB = rg.y * (1.0f / S_Y8); }
        u32x4 nx[2][2], na[2], nb[2];
#define LNB_LOAD(pr, nx, na, nb) do { _Pragma("unroll") for (int i = 0; i < 2; ++i) { const int rr_ = 2 * (pr) + i; const int sa_ = __builtin_amdgcn_readlane(sA, rr_), sb_ = __builtin_amdgcn_readlane(sB, rr_); \
            const unsigned char* ya_ = YE + (size_t)sa_ * DM; const unsigned char* yb_ = YE + (size_t)sb_ * DM; const bf16_t* xr_ = X1 + (size_t)(mb + rr_) * DM; \
            nx[i][0] = *(const u32x4*)(xr_ + 16 * lane); nx[i][1] = *(const u32x4*)(xr_ + 16 * lane + 8); na[i] = *(const u32x4*)(ya_ + 16 * lane); nb[i] = *(const u32x4*)(yb_ + 16 * lane); } } while (0)
        LNB_LOAD(0, nx, na, nb);
#pragma unroll 1
        for (int pr = 0; pr < 8; ++pr) {
            u32x4 x[2][2], wa[2], wb[2];
#pragma unroll
            for (int i = 0; i < 2; ++i) { x[i][0] = nx[i][0]; x[i][1] = nx[i][1]; wa[i] = na[i]; wb[i] = nb[i]; }
            if (pr < 7) LNB_LOAD(pr + 1, nx, na, nb);
#pragma unroll
            for (int i = 0; i < 2; ++i) {
                const int rr = 2 * pr + i; const int m = mb + rr;
                const float ga = __builtin_bit_cast(float, __builtin_amdgcn_readlane(__builtin_bit_cast(int, gA), rr)), gb = __builtin_bit_cast(float, __builtin_amdgcn_readlane(__builtin_bit_cast(int, gB), rr));
                f32x4 v[4]; float s = 0.f;
                float s0 = 0.f;
#pragma unroll
                for (int j = 0; j < 4; ++j) { const unsigned xl_ = x[i][j >> 1][2 * (j & 1)], xh_ = x[i][j >> 1][2 * (j & 1) + 1]; v[j] = (f32x4){bf_lo(xl_), bf_hi(xl_), bf_lo(xh_), bf_hi(xh_)}; s0 += (v[j][0] + v[j][1]) + (v[j][2] + v[j][3]); }
                const float mean0 = wave_sum(s0) * (1.f / DM); float q0 = 0.f;
#pragma unroll
                for (int j = 0; j < 4; ++j) { v[j] = v[j] - mean0; q0 += (v[j][0] * v[j][0] + v[j][1] * v[j][1]) + (v[j][2] * v[j][2] + v[j][3] * v[j][3]); }
                const float rstd0 = __builtin_amdgcn_rsqf(wave_sum(q0) * (1.f / DM) + LN_EPS);
#pragma unroll
                for (int j = 0; j < 4; ++j) {
                    const f32x2 a01 = __builtin_amdgcn_cvt_pk_f32_fp8((int)wa[i][j], false), a23 = __builtin_amdgcn_cvt_pk_f32_fp8((int)wa[i][j], true), b01 = __builtin_amdgcn_cvt_pk_f32_fp8((int)wb[i][j], false), b23 = __builtin_amdgcn_cvt_pk_f32_fp8((int)wb[i][j], true);
                    const f32x4 y = (f32x4){a01.x, a01.y, a23.x, a23.y} * ga + (f32x4){b01.x, b01.y, b23.x, b23.y} * gb;
                    v[j] = v[j] * rstd0 * gmA[j] + bmA[j] + pg2[j] * y; s += (v[j][0] + v[j][1]) + (v[j][2] + v[j][3]); }
                const float mean = wave_sum(s) * (1.f / DM); float s2 = 0.f;
#pragma unroll
                for (int j = 0; j < 4; ++j) { v[j] = v[j] - mean; s2 += (v[j][0] * v[j][0] + v[j][1] * v[j][1]) + (v[j][2] * v[j][2] + v[j][3] * v[j][3]); }
                const float rstd = __builtin_amdgcn_rsqf(wave_sum(s2) * (1.f / DM) + LN_EPS);
                u32x4 wxa, wxb, h8;
#pragma unroll
                for (int j = 0; j < 4; ++j) { const f32x4 x2 = v[j] * rstd * plg[j] + plb[j];
                    if (l + 1 >= NL) st16_wt(P.out, (unsigned)((m * DM + 16 * lane + 4 * j) * 4), __builtin_bit_cast(u32x4, x2));
                    else { const unsigned x_lo = cvtpk(x2[0], x2[1]), x_hi = cvtpk(x2[2], x2[3]); if (j < 2) { wxa[2 * j] = x_lo; wxa[2 * j + 1] = x_hi; } else { wxb[2 * j - 4] = x_lo; wxb[2 * j - 3] = x_hi; }
                        const f32x4 h = (x2 * psc[j] + psh[j]) * S_H8; h8[j] = cvt4_fp8(h[0], h[1], h[2], h[3]); } }
                if (l + 1 < NL) { st16_wt(XB, (unsigned)((m * DM + 16 * lane) * 2), wxa); st16_wt(XB, (unsigned)((m * DM + 16 * lane) * 2 + 16), wxb); st16_wt(H, (unsigned)(m * DM + 16 * lane), h8); }
            }
        }
#undef LNB_LOAD
    }
    __syncthreads();
    if (l + 1 < NL) { if (G == 256) { convert_weights(P, l + 1, lds, vcu * 8 + wave, G * 8, wave, lane, 7168 + vcu * 8 + wave, G * 8, 8192, false);
            convert_weights(P, l + 1, lds, vcu * 8 + wave, G * 8, wave, lane, 12288 + vcu * 8 + wave, G * 8, 16 * 28 + 16 * 16 + 3 * 32 * 128, true); }
        else convert_weights(P, l + 1, lds, vcu * 8 + wave, G * 8, wave, lane); }
}

template <bool GATEUP>
__device__ __forceinline__ void phase_moe(const Params& P, int l, LAS unsigned char* lds, int vcu, int G) {
    if (GATEUP || !MK_ONE_LAUNCH) moe_table(P, l, lds, vcu);
    const LAS int* ts = (const LAS int*)(lds + LDS_TS); const LAS int* cn = (const LAS int*)(lds + LDS_TS + 256); const LAS int* ue = (const LAS int*)(lds + LDS_TS + 384);
    MoeOrder S; S.vcu = vcu; S.ntile = ts[NE]; S.ue = ue;
    if (GATEUP) {
        const int* list = (const int*)(P.ws + WS_LIST); LAS int* tok = (LAS int*)(lds + LDS_TOK);
        for (int idx = phase_tid(); idx < 8 * 256; idx += 512) { const int i = idx >> 8, r = idx & 255; const int e = ue[i];
            if (e >= 0) { const int tile = (i * 256 + vcu) >> 2; const int rr = (tile - ts[e]) * 256 + r; tok[idx] = list[(size_t)e * 65536 + (rr < cn[e] ? rr : 0)]; } }
        __syncthreads();
        S.Abase = (const char*)(P.ws + WS_H8); S.Wbase = (const char*)(P.ws + ((l & 1) ? WS_WGU1 : WS_WGU)); S.wstride = (size_t)1024 * 1024; S.rowbytes = DM; S.gather = true;
        EpiGateUp E{(unsigned char*)(P.ws + WS_ACT)};
        pg8::gemm_phase<EpiGateUp, MoeOrder, true, true, ((REP_MASK >> 12) & 1) != 0>(lds, lds + LDS_TOK, DM, S, E);
        if (SPARE_CONV && G == 256 && vcu >= 128) { const int tid_ = phase_tid(), w_ = tid_ >> 6; const int wi = (vcu - 128) * 8 + w_;
            convert_weights(P, l, lds, 0, 1, w_, tid_ & 63, 8192 + wi, 1024, 12288, false); }
    } else {
        { LAS int* tok = (LAS int*)(lds + LDS_TOK);
          for (int idx = phase_tid(); idx < 8 * 256; idx += 512) { const int i = idx >> 8, r = idx & 255; tok[idx] = (((i * 256 + vcu) >> 2) << 8) + r; }
          __syncthreads(); }
        S.Abase = (const char*)(P.ws + WS_ACT); S.Wbase = (const char*)(P.ws + ((l & 1) ? WS_WD1 : WS_WD)); S.wstride = (size_t)1024 * 512; S.rowbytes = DE; S.gather = true;
        EpiDown E{P.ws + WS_YE};
        pg8::gemm_phase<EpiDown, MoeOrder, true, true, ((REP_MASK >> 13) & 1) != 0>(lds, lds + LDS_TOK, DE, S, E);
        if (SPARE_CONV && G == 256 && l + 1 < NL && vcu >= 128) { const int tid_ = phase_tid(), w_ = tid_ >> 6; const int wi = (vcu - 128) * 8 + w_;
            convert_weights(P, l + 1, lds, 0, 1, w_, tid_ & 63, 4096 + wi, 1024, 7168, false); }
    }
}

constexpr int N_PHASES = 2 + 7 * NL;
__global__ void __launch_bounds__(512, 2) enc_fwd(Params P0) {
    extern __shared__ __attribute__((aligned(16))) unsigned char lds_raw[];
    LAS unsigned char* lds = (LAS unsigned char*)lds_raw;
    const int tid = threadIdx.x;
#if FP8_ASM_CLAMP
    asm volatile("s_setreg_imm32_b32 hwreg(HW_REG_MODE, 23, 1), 1");
#endif
    const int G = gridDim.x; const int bx = blockIdx.x; const int vcu = (G % 8 == 0) ? (bx % 8) * (G / 8) + bx / 8 : bx;
    const int G_ = G, bx_ = bx, vcu_ = vcu;
    volatile LAS unsigned* MISC = (volatile LAS unsigned*)(lds + LDS_MISC);
    if (tid < 32) MISC[tid] = 0u;
    __syncthreads();
    unsigned* ctl = (unsigned*)(P0.ws + WS_CTL);
    XcdBarrier bar; bar.bar = ctl + CW_BAR; bar.x = 0; bar.st = nullptr;
    if (P0.use_bar) bar = xcd_barrier_post(ctl + CW_BAR, MISC + 8);
    if (P0.never) cg::this_grid().sync();
#define SEAM(k) do { if (P0.use_bar && (k) + 1 < P0.ph_hi) { xcd_barrier(bar); if ((REP_MASK >> 11) & 1) { xcd_barrier(bar); xcd_barrier(bar); } } } while (0)
#ifndef PH_MASK
#define PH_MASK 0x1ff
#endif
#define PHK(k) ((k) < 2 ? (k) : 2 + ((k) - 2) % 7)
#define IN(k) (((PH_MASK >> PHK(k)) & 1) && P0.ph_lo <= (k) && (k) < P0.ph_hi)
#define REP(bit) ((REP_MASK >> (bit)) & 1)
#define RBAR() do { if (P0.use_bar) xcd_barrier(bar); } while (0)
    if (IN(0)) { phase_prep(P0, lds, vcu, G); if (REP(0)) { RBAR(); phase_prep(P0, lds, vcu, G); } SEAM(0); }
    if (IN(1)) { phase_h0(P0, vcu, G); if (REP(1)) { RBAR(); phase_h0(P0, vcu, G); } SEAM(1); }
#pragma unroll 1
    for (int l = 0; l < NL; ++l) {
        const int p0 = 2 + 7 * l;
        Params Q = P0; { GAS unsigned char* w_ = (GAS unsigned char*)P0.ws; GAS float* o_ = (GAS float*)P0.out; asm volatile("" : "+s"(w_), "+s"(o_)); Q.ws = (unsigned char*)w_; Q.out = (float*)o_; }
        const Params& P = Q;
        int bxl = bx_, vcul = vcu_, Gl = G_; asm volatile("" : "+s"(bxl), "+s"(vcul), "+s"(Gl));
        const int bx = bxl, vcu = vcul, G = Gl;
        if (IN(p0 + 0)) {
#pragma unroll 1
            for (int rep = 0; rep < 1 + REP(2); ++rep) { if (rep) RBAR();
            pg8::DenseOrder S; S.init(P.ws + WS_H, P.ws + WS_WIN, NT, INW, DM / 2, G, bx); S.gather = true;
            { LAS int* tok = (LAS int*)(lds + LDS_TOK); pg8::GUnit uu;
              for (int i = 0; i < 8 && S.next(i, uu); ++i) for (int r = phase_tid(); r < 256; r += 512) tok[i * 256 + r] = uu.orow + r;
              __syncthreads(); }
            EpiInProj E{(bf16_t*)(P.ws + WS_Z), P.in[I_BIN] + l * INW, 1.0f / (S_H8 * S_W8)};
            pg8::gemm_phase<EpiInProj, pg8::DenseOrder, true, true, ((REP_MASK >> 14) & 1) != 0>(lds, lds + LDS_TOK, DM, S, E);
            if (SPARE_CONV && G == 256 && !rep && bx >= 128) { const int tid_ = phase_tid(), w_ = tid_ >> 6; const int wi = (bx - 128) * 8 + w_;
                convert_weights(P, l, lds, 0, 1, w_, tid_ & 63, wi, 1024, 4096, false); } }
            SEAM(p0 + 0);
        }
        if (IN(p0 + 1)) {
#pragma unroll 1
            for (int rep = 0; rep < 1 + REP(3); ++rep) { if (rep) RBAR(); phase_mixers(P, l, lds, vcu, G); }
            SEAM(p0 + 1); }
        if (IN(p0 + 2)) {
#pragma unroll 1
            for (int rep = 0; rep < 1 + REP(4); ++rep) { if (rep) RBAR();
            pg8::DenseOrder S; S.init(P.ws + WS_YCAT, P.ws + WS_WOUT, NT, DM, DM / 2, G, bx); S.gather = true;
            { LAS int* tok = (LAS int*)(lds + LDS_TOK); pg8::GUnit uu;
              for (int i = 0; i < 8 && S.next(i, uu); ++i) for (int r = phase_tid(); r < 256; r += 512) tok[i * 256 + r] = uu.orow + r;
              __syncthreads(); }
            EpiOutProj E{(bf16_t*)(P.ws + WS_R), l == 0 ? P.in[I_X] : nullptr, (const bf16_t*)(P.ws + WS_XB), P.in[I_BOUT] + l * DM, (const float*)(P.ws + WS_MOD) + (size_t)l * 8 * 6144 + 2048};
            pg8::gemm_phase<EpiOutProj, pg8::DenseOrder, true, true>(lds, lds + LDS_TOK, DM, S, E); }
            SEAM(p0 + 2);
        }
        if (IN(p0 + 3)) {
#pragma unroll 1
            for (int rep = 0; rep < 1 + REP(5); ++rep) { if (rep) RBAR(); phase_ln_a(P, l, lds, vcu, G, rep != 0); }
            SEAM(p0 + 3); }
        if (IN(p0 + 4)) {
#pragma unroll 1
            for (int rep = 0; rep < 1 + REP(6); ++rep) { if (rep) RBAR(); phase_moe<true>(P, l, lds, vcu, G); }
            SEAM(p0 + 4); }
        if (IN(p0 + 5)) {
#pragma unroll 1
            for (int rep = 0; rep < 1 + REP(7); ++rep) { if (rep) RBAR(); phase_moe<false>(P, l, lds, vcu, G); }
            SEAM(p0 + 5); }
        if (IN(p0 + 6)) {
#pragma unroll 1
            for (int rep = 0; rep < 1 + REP(8); ++rep) { if (rep) RBAR(); phase_ln_b(P, l, lds, vcu, G); }
            SEAM(p0 + 6); }
    }
#undef SEAM
#undef IN
}

extern "C" void kernel_launch(void* const* d_in, const int* in_sizes, int n_in, void* d_out, int out_size, void* d_ws, size_t ws_size, hipStream_t stream) {
    static int grid = 0;
    if (grid == 0) {
        if (n_in != 27 || out_size != NT * DM || ws_size < WS_END) { fprintf(stderr, "kernel_launch: unexpected shapes (n_in %d out %d ws %zu)\n", n_in, out_size, ws_size); grid = -1; return; }
        int dev = 0, cus = 0, per_cu = 0;
        hipGetDevice(&dev); hipDeviceGetAttribute(&cus, hipDeviceAttributeMultiprocessorCount, dev);
        hipFuncSetAttribute((const void*)enc_fwd, hipFuncAttributeMaxDynamicSharedMemorySize, LDS_BYTES);
        hipOccupancyMaxActiveBlocksPerMultiprocessor(&per_cu, (const void*)enc_fwd, 512, LDS_BYTES);
        (void)hipGetLastError();
        if (per_cu < 1) { fprintf(stderr, "kernel_launch: occupancy query says %d blocks/CU\n", per_cu); per_cu = 1; }
        grid = cus;
        if (grid != 256) fprintf(stderr, "kernel_launch: note: %d CUs\n", grid);
    }
    if (grid < 0) return;
    hipMemsetAsync((char*)d_ws + WS_CTL, 0, CTL_BYTES, stream);
    Params p{};
    for (int i = 0; i < 27; ++i) p.in[i] = (const float*)d_in[i];
    p.out = (float*)d_out; p.ws = (unsigned char*)d_ws; p.never = 0;
#if MK_ONE_LAUNCH
    p.ph_lo = 0; p.ph_hi = N_PHASES; p.use_bar = 1;
    void* args[] = {&p};
    hipError_t e = hipLaunchCooperativeKernel((const void*)enc_fwd, dim3(grid), dim3(512), args, LDS_BYTES, stream);
    if (e != hipSuccess) fprintf(stderr, "cooperative launch failed: %s\n", hipGetErrorString(e));
#else
    for (int ph = 0; ph < N_PHASES; ++ph) { p.ph_lo = ph; p.ph_hi = ph + 1; p.use_bar = 0;
        hipLaunchKernelGGL(enc_fwd, dim3(grid), dim3(512), LDS_BYTES, stream, p); }
#endif
}
```

```cpp
#include <hip/hip_runtime.h>
#include <hip/hip_cooperative_groups.h>
#include <cstdint>
#include <cstdio>
namespace cg = cooperative_groups;

#ifndef REP_MASK
#define REP_MASK 0x0
#endif
#ifndef SPARE_CONV
#define SPARE_CONV 1
#endif
#ifndef MK_ONE_LAUNCH
#define MK_ONE_LAUNCH 1
#endif

#define LAS __attribute__((address_space(3)))
#define GAS __attribute__((address_space(1)))
typedef unsigned short bf16_t;
typedef short bf16x8 __attribute__((ext_vector_type(8)));
typedef short s16x4 __attribute__((ext_vector_type(4)));
typedef short v4i16_t __attribute__((ext_vector_type(4)));
typedef float f32x2 __attribute__((ext_vector_type(2)));
typedef float f32x4 __attribute__((ext_vector_type(4)));
typedef float f32x16 __attribute__((ext_vector_type(16)));
typedef unsigned u32x2 __attribute__((ext_vector_type(2)));
typedef unsigned u32x4 __attribute__((ext_vector_type(4)));
typedef int i32x4 __attribute__((ext_vector_type(4)));
typedef int i32x8 __attribute__((ext_vector_type(8)));
typedef __bf16 bf16x2_t __attribute__((ext_vector_type(2)));

constexpr int NB = 8, SEQ = 4096, DM = 1024, NT = NB * SEQ, NL = 2;
constexpr int INW = 1792, ZW = 1536, NE = 32, DE = 512;
constexpr int NSLOT = 73728;
constexpr float ALPHA = 1.4142135623730951f;
constexpr float LN_EPS = 1e-5f;
constexpr float LOG2E = 1.4426950408889634f;
constexpr float QSCALE = 0.125f * LOG2E;
constexpr float S_H8 = 16.f, S_W8 = 256.f, S_ACT8 = 8.f, S_Y8 = 32.f, S_YC8 = 8.f;

constexpr size_t MiB = 1u << 20;
constexpr size_t WS_CTL = 0, CTL_BYTES = 1 * MiB + 512 * 1024;
constexpr size_t WS_MOD = 1 * MiB;
constexpr size_t WS_BTAB = 1 * MiB + 512 * 1024;
constexpr size_t WS_WSB = 1 * MiB + 768 * 1024;
constexpr size_t WS_RINFO = 2 * MiB;
constexpr size_t WS_RGATE = 3 * MiB;
constexpr size_t WS_STATS = 3 * MiB + 512 * 1024;
constexpr size_t WS_LIST = 4 * MiB;
constexpr size_t WS_WIN = 12 * MiB;
constexpr size_t WS_WOUT = 16 * MiB;
constexpr size_t WS_WGU = 18 * MiB;
constexpr size_t WS_H8 = 50 * MiB;
constexpr size_t WS_WD = 82 * MiB;
constexpr size_t WS_H = 114 * MiB;
constexpr size_t WS_R = 178 * MiB;
constexpr size_t WS_XB = 242 * MiB;
constexpr size_t WS_ARENA = 306 * MiB;
constexpr size_t WS_Z = WS_ARENA;
constexpr size_t WS_YCAT = WS_ARENA + 128 * MiB;
constexpr size_t WS_YE = WS_ARENA;
constexpr size_t WS_ACT = WS_ARENA + 144 * MiB;
constexpr size_t WS_WGU1 = WS_ARENA + 216 * MiB;
constexpr size_t WS_WD1 = 98 * MiB;
constexpr size_t WS_END = WS_ARENA + 248 * MiB;
constexpr int CW_CNT = 8192;
constexpr int CW_BAR = 4096;

constexpr int RING_BYTES = 131072;
constexpr int LDS_TOK = RING_BYTES;
constexpr int LDS_TS = RING_BYTES + 8192;
constexpr int LDS_MISC = 147200;
constexpr int LDS_BYTES = 147456;
constexpr int LDS_PFD = 140288;

__device__ __forceinline__ unsigned cvtpk(float lo, float hi) { f32x2 v = {lo, hi}; bf16x2_t b = __builtin_convertvector(v, bf16x2_t); return __builtin_bit_cast(unsigned, b); }
#ifndef FP8_ASM_CLAMP
#define FP8_ASM_CLAMP 1
#endif
__device__ __forceinline__ unsigned cvt4_fp8(float a, float b, float c, float d) {
#if FP8_ASM_CLAMP
    int w = __builtin_amdgcn_cvt_pk_fp8_f32(a, b, 0, false); w = __builtin_amdgcn_cvt_pk_fp8_f32(c, d, w, true); return (unsigned)w;
#else
    a = __builtin_amdgcn_fmed3f(a, -448.f, 448.f); b = __builtin_amdgcn_fmed3f(b, -448.f, 448.f); c = __builtin_amdgcn_fmed3f(c, -448.f, 448.f); d = __builtin_amdgcn_fmed3f(d, -448.f, 448.f);
    int w = __builtin_amdgcn_cvt_pk_fp8_f32(a, b, 0, false); w = __builtin_amdgcn_cvt_pk_fp8_f32(c, d, w, true); return (unsigned)w;
#endif
}
__device__ __forceinline__ float bf_lo(unsigned w) { return __uint_as_float(w << 16); }
__device__ __forceinline__ float bf_hi(unsigned w) { return __uint_as_float(w & 0xffff0000u); }
template <int CTRL> __device__ __forceinline__ int dpp_i(int v) { return __builtin_amdgcn_update_dpp(0, v, CTRL, 0xf, 0xf, true); }
__device__ __forceinline__ int swap16_i(int v, int) { const auto r = __builtin_amdgcn_permlane16_swap((unsigned)v, (unsigned)v, false, false); return ((int)r[0] != v) ? (int)r[0] : (int)r[1]; }
__device__ __forceinline__ int swap32_i(int v, int) { const auto r = __builtin_amdgcn_permlane32_swap((unsigned)v, (unsigned)v, false, false); return ((int)r[0] != v) ? (int)r[0] : (int)r[1]; }
template <int M> __device__ __forceinline__ int xlane_i(int v, int lane) {
    if constexpr (M & 32) v = swap32_i(v, lane);
    if constexpr (M & 16) v = swap16_i(v, lane);
    constexpr int m = M & 15;
    if constexpr (m >= 8) { v = dpp_i<0x140>(v); constexpr int m2 = m ^ 15;
        if constexpr (m2 >= 4) { v = dpp_i<0x141>(v); constexpr int m3 = m2 ^ 7; if constexpr (m3 == 1) v = dpp_i<0xB1>(v); else if constexpr (m3 == 2) v = dpp_i<0x4E>(v); else if constexpr (m3 == 3) v = dpp_i<0x1B>(v); }
        else if constexpr (m2 == 1) v = dpp_i<0xB1>(v); else if constexpr (m2 == 2) v = dpp_i<0x4E>(v); else if constexpr (m2 == 3) v = dpp_i<0x1B>(v); }
    else if constexpr (m >= 4) { v = dpp_i<0x141>(v); constexpr int m3 = m ^ 7;
        if constexpr (m3 == 1) v = dpp_i<0xB1>(v); else if constexpr (m3 == 2) v = dpp_i<0x4E>(v); else if constexpr (m3 == 3) v = dpp_i<0x1B>(v); }
    else if constexpr (m == 1) v = dpp_i<0xB1>(v); else if constexpr (m == 2) v = dpp_i<0x4E>(v); else if constexpr (m == 3) v = dpp_i<0x1B>(v);
    return v;
}
template <int M> __device__ __forceinline__ float xlane_f(float v, int lane) { return __int_as_float(xlane_i<M>(__float_as_int(v), lane)); }
__device__ __forceinline__ float sum_halves(float v) { const auto r = __builtin_amdgcn_permlane32_swap(__float_as_uint(v), __float_as_uint(v), false, false); return __uint_as_float(r[0]) + __uint_as_float(r[1]); }
__device__ __forceinline__ float max_halves(float v) { const auto r = __builtin_amdgcn_permlane32_swap(__float_as_uint(v), __float_as_uint(v), false, false); return fmaxf(__uint_as_float(r[0]), __uint_as_float(r[1])); }
__device__ __forceinline__ float wave_sum(float v) {
    v += __int_as_float(dpp_i<0xB1>(__float_as_int(v))); v += __int_as_float(dpp_i<0x4E>(__float_as_int(v)));
    v += __int_as_float(dpp_i<0x141>(__float_as_int(v))); v += __int_as_float(dpp_i<0x140>(__float_as_int(v)));
    { const auto r = __builtin_amdgcn_permlane16_swap(__float_as_uint(v), __float_as_uint(v), false, false); v = __uint_as_float(r[0]) + __uint_as_float(r[1]); }
    return sum_halves(v);
}
__device__ __forceinline__ float fast_exp2(float x) { return __builtin_amdgcn_exp2f(x); }
__device__ __forceinline__ float fast_rcp(float x) { return __builtin_amdgcn_rcpf(x); }
__device__ __forceinline__ float sigmoid_f(float x) { return fast_rcp(1.f + fast_exp2(-LOG2E * x)); }
__device__ __forceinline__ float silu_f(float x) { return x * sigmoid_f(x); }
__device__ __forceinline__ float gelu_tanh_f(float x) {
    const float u = x * (1.f + 0.044715f * x * x);
    return x * fast_rcp(1.f + fast_exp2(-2.f * 0.7978845608028654f * LOG2E * u));
}
__device__ __forceinline__ int phase_tid() { int t = threadIdx.x; asm volatile("" : "+v"(t)); return t; }
#define RCOL(lane, j) (16 * (lane) + 4 * (j))
#ifndef ST16_AUX
#define ST16_AUX 0
#endif
__device__ __forceinline__ void st16_wt(const void* base, unsigned off, u32x4 v) {
    const __amdgpu_buffer_rsrc_t r = __builtin_amdgcn_make_buffer_rsrc((void*)base, (short)0, 0x7ffff000, 0x00020000);
    __builtin_amdgcn_raw_buffer_store_b128(v, r, off, 0,   ST16_AUX); }
__device__ __forceinline__ u32x4 ld16_buf(const void* base, unsigned voff, unsigned soff) {
    const __amdgpu_buffer_rsrc_t r = __builtin_amdgcn_make_buffer_rsrc((void*)base, (short)0, 0x7ffff000, 0x00020000);
    return __builtin_amdgcn_raw_buffer_load_b128(r, voff, soff, 0); }
#define LDS_WAIT() asm volatile("s_waitcnt lgkmcnt(0)" ::: "memory")
#define VM_WAIT() asm volatile("s_waitcnt vmcnt(0)" ::: "memory")

namespace pg8 {
constexpr int BM = 256, BK = 64, HALF = 128, HTB = HALF * BK * 2, NXCD = 8, WGM = 8;
__host__ __device__ __forceinline__ int lds_byte(int r, int c) { const int st = (r >> 4) * 2 + (c >> 5), rr = r & 15, cc = c & 31, ob = rr * 64 + cc * 2; return st * 1024 + (ob ^ (((ob >> 9) & 1) << 5)); }
__host__ __device__ __forceinline__ void stage_rc(int b, int& R, int& C) { const int st = b / 1024, sb = b % 1024, swz = sb ^ (((sb >> 9) & 1) << 5); R = (st >> 1) * 16 + swz / 64; C = (st & 1) * 32 + (swz % 64) / 2; }
__host__ __device__ __forceinline__ int perm32(int rho) { const int n = rho >> 4, i = rho & 15; return 8 * (i >> 2) + 4 * n + (i & 3); }

struct GUnit { const char* A; const char* B; int orow; int pn; int aux; int tokoff; };

struct DenseOrder {
    const char* Abase; const char* Bbase; int RB; int nM, nN, nwg, G, c; bool gather = false;
    __device__ __forceinline__ void init(const void* A, const void* Bt, int M, int N, int K_, int G_, int c_) { Abase = (const char*)A; Bbase = (const char*)Bt; RB = K_ * 2; nM = M / BM; nN = N / BM; nwg = nM * nN; G = G_; c = c_; }
    __device__ __forceinline__ bool next(int i, GUnit& u) const {
        const long L = (long)i * G + c; if (L >= nwg) return false;
        int wgid = (int)L; { const int q = nwg / NXCD, r = nwg % NXCD, xcd = wgid % NXCD, off = wgid / NXCD; wgid = (xcd < r ? xcd * (q + 1) : r * (q + 1) + (xcd - r) * q) + off; }
        const int nig = WGM * nN, gid = wgid / nig, fm = gid * WGM, gsz = (nM - fm) < WGM ? (nM - fm) : WGM;
        const int pm = fm + ((wgid % nig) % gsz), pn = (wgid % nig) / gsz;
        u.A = gather ? Abase : Abase + (size_t)pm * BM * RB; u.B = Bbase + (size_t)pn * BM * RB; u.orow = pm * BM; u.pn = pn; u.aux = 0; u.tokoff = i * 1024; return true;
    }
};

template <class Epi, class Sched, bool GATHER, bool FP8 = false, bool EPI2 = false>
__device__ __forceinline__ void gemm_phase(LAS unsigned char* lds, LAS unsigned char* toklds, const int RB, const Sched& S, const Epi& E) {
    const int tid = phase_tid(), wid = __builtin_amdgcn_readfirstlane(tid >> 6), lane = tid & 63, wr = wid >> 2, wc = wid & 3, fr = lane & 15, fq = lane >> 4;
    int nt = RB / 128; asm volatile("" : "+s"(nt));
    unsigned voffA[2][2], voffB[2]; int rowA[2], colA2[2];
#pragma unroll
    for (int i = 0; i < 2; ++i) { int R, C; stage_rc(tid * 16 + i * 8192, R, C); const int Rb = Epi::PERM ? ((R & ~31) + perm32(R & 31)) : R;
        rowA[i] = R; colA2[i] = C * 2;
        voffA[0][i] = (unsigned)(R * RB + C * 2); voffA[1][i] = (unsigned)((R + HALF) * RB + C * 2); voffB[i] = (unsigned)(Rb * RB + C * 2); }
    const size_t kstep = (size_t)(BK * 2);
    const size_t hstep = (size_t)HALF * RB;
    const unsigned ldsw = (unsigned)wid * 1024u;
    const int aoff = lds_byte(wr * 64 + fr, fq * 8), boff = lds_byte(wc * 32 + fr, fq * 8);
#define PG8_SA(b, h) (((b) * 2 + (h)) * HTB)
#define PG8_SB(b, h) ((4 + (b) * 2 + (h)) * HTB)
#define PG8_STAGE(bufoff, gbase, voff) do { _Pragma("unroll") for (int _i = 0; _i < 2; ++_i) \
        __builtin_amdgcn_global_load_lds((const unsigned*)((const char*)(gbase) + (voff)[_i]), (LAS unsigned*)(lds + (bufoff) + ldsw + _i * 8192), 16, 0, 0); } while (0)
#define PG8_LDA(dst, b, h) do { _Pragma("unroll") for (int m = 0; m < 4; ++m) _Pragma("unroll") for (int k = 0; k < 2; ++k) dst[m][k] = *(const LAS bf16x8*)(lds + PG8_SA(b, h) + aoff + m * 2048 + k * 1024); } while (0)
#define PG8_LDB(dst, b, h) do { _Pragma("unroll") for (int n = 0; n < 2; ++n) _Pragma("unroll") for (int k = 0; k < 2; ++k) dst[n][k] = *(const LAS bf16x8*)(lds + PG8_SB(b, h) + boff + n * 2048 + k * 1024); } while (0)
#define PG8_MMA(ai, bj, At, Bt) do { __builtin_amdgcn_s_setprio(1); if constexpr (FP8) { _Pragma("unroll") for (int m = 0; m < 4; ++m) _Pragma("unroll") for (int n = 0; n < 2; ++n) { \
            const i32x8 bo_ = __builtin_shufflevector(__builtin_bit_cast(i32x4, Bt[n][0]), __builtin_bit_cast(i32x4, Bt[n][1]), 0, 1, 2, 3, 4, 5, 6, 7); \
            const i32x8 ao_ = __builtin_shufflevector(__builtin_bit_cast(i32x4, At[m][0]), __builtin_bit_cast(i32x4, At[m][1]), 0, 1, 2, 3, 4, 5, 6, 7); \
            acc[ai][bj][m][n] = __builtin_amdgcn_mfma_scale_f32_16x16x128_f8f6f4(bo_, ao_, acc[ai][bj][m][n], 0, 0, 0, (bj) == 0 ? Epi::SC0 : Epi::SC1, 0, 0x7F7F7F7F); } } \
        else { _Pragma("unroll") for (int m = 0; m < 4; ++m) _Pragma("unroll") for (int n = 0; n < 2; ++n) _Pragma("unroll") for (int k = 0; k < 2; ++k) \
            acc[ai][bj][m][n] = __builtin_amdgcn_mfma_f32_16x16x32_bf16(Bt[n][k], At[m][k], acc[ai][bj][m][n], 0, 0, 0); } __builtin_amdgcn_s_setprio(0); } while (0)
#define PG8_WAIT_V(n) asm volatile("s_waitcnt vmcnt(" #n ")" ::: "memory")
#define PG8_WAIT_L(n) asm volatile("s_waitcnt lgkmcnt(" #n ")" ::: "memory")
#define PG8_WAIT_VR(NV) asm volatile("s_waitcnt vmcnt(%1)\n\ts_cmp_eq_u32 %0, 0\n\ts_cbranch_scc1 .Lpg8rw%=\n\ts_waitcnt vmcnt(8)\n.Lpg8rw%=:" :: "s"(t), "n"(8 + (NV)) : "scc", "memory")
#define PG8_BAR __builtin_amdgcn_s_barrier()
#define PG8_SCHED __builtin_amdgcn_sched_barrier(0)
#define PG8_GATHER_OFFS(u_) do { if constexpr (GATHER) { _Pragma("unroll") for (int _h = 0; _h < 2; ++_h) _Pragma("unroll") for (int _i = 0; _i < 2; ++_i) { \
        const int _tok = *(const LAS int*)(toklds + (u_).tokoff + (_h * HALF + rowA[_i]) * 4); voffA[_h][_i] = (unsigned)_tok * (unsigned)RB + (unsigned)colA2[_i]; } } } while (0)
    GUnit cur, nxt; int ui = 0;
    if (!S.next(0, cur)) return;
    f32x4 acc[2][2][4][2];
#pragma unroll
    for (int a = 0; a < 2; ++a)
#pragma unroll
        for (int b = 0; b < 2; ++b)
#pragma unroll
            for (int m = 0; m < 4; ++m)
#pragma unroll
                for (int n = 0; n < 2; ++n) acc[a][b][m][n] = (f32x4){0.f, 0.f, 0.f, 0.f};
    bf16x8 At[4][2], B0[2][2], B1[2][2];
    const char* cA = cur.A; const char* cB = cur.B;
    asm volatile("" : "+s"(cA), "+s"(cB));
    PG8_GATHER_OFFS(cur);
    PG8_STAGE(PG8_SB(0, 0), cB, voffB); PG8_STAGE(PG8_SB(0, 1), cB + hstep, voffB); PG8_STAGE(PG8_SA(0, 0), cA, voffA[0]); PG8_STAGE(PG8_SA(0, 1), cA, voffA[1]);
    if (wr == 1) PG8_BAR;
    PG8_WAIT_V(2); PG8_BAR;
    PG8_STAGE(PG8_SB(1, 0), cB + kstep, voffB); PG8_STAGE(PG8_SA(1, 0), cA + kstep, voffA[0]); PG8_STAGE(PG8_SB(1, 1), cB + hstep + kstep, voffB);
    PG8_WAIT_V(6); PG8_BAR;
    if constexpr (Epi::NVM > 0) {
#pragma unroll
        for (int d = 0; d < Epi::NVM; ++d) __builtin_amdgcn_global_load_lds((const unsigned*)cB, (LAS unsigned*)(lds + LDS_PFD + ldsw / 4), 4, 0, 0); }
    for (;;) {
        asm volatile("" : "+v"(voffA[0][0]), "+v"(voffA[0][1]), "+v"(voffA[1][0]), "+v"(voffA[1][1]), "+v"(voffB[0]), "+v"(voffB[1]));
        const bool has_next = S.next(ui + 1, nxt);
        const char* nA = has_next ? nxt.A : cA; const char* nB = has_next ? nxt.B : cB;
#pragma unroll 1
        for (int t = 0; t < nt; t += 2) {
            const bool last = (t == nt - 2);
            const char* a1 = cA + (size_t)(t + 1) * kstep;
            const char* a2 = last ? nA : cA + (size_t)(t + 2) * kstep; const char* b2 = last ? nB : cB + (size_t)(t + 2) * kstep;
            const char* a3 = a2 + kstep; const char* b3 = b2 + kstep;
            PG8_LDB(B0, 0, 0); PG8_LDB(B1, 0, 1); PG8_SCHED; PG8_LDA(At, 0, 0); PG8_STAGE(PG8_SA(1, 1), a1, voffA[1]);
            if (GATHER && last && has_next) { PG8_GATHER_OFFS(nxt); }
            if constexpr (Epi::NVM > 0) PG8_WAIT_VR(Epi::NVM); else PG8_WAIT_V(8);
            PG8_WAIT_L(0); PG8_BAR; PG8_MMA(0, 0, At, B0); PG8_MMA(0, 1, At, B1); PG8_BAR; PG8_SCHED;
            PG8_LDA(At, 0, 1); PG8_STAGE(PG8_SB(0, 0), b2, voffB); PG8_STAGE(PG8_SB(0, 1), b2 + hstep, voffB); PG8_STAGE(PG8_SA(0, 0), a2, voffA[0]);
            if constexpr (Epi::NVM > 0) PG8_WAIT_VR(Epi::NVM); else PG8_WAIT_V(8);
            PG8_WAIT_L(0); PG8_BAR; PG8_MMA(1, 0, At, B0); PG8_MMA(1, 1, At, B1); PG8_BAR; PG8_SCHED;
            PG8_LDB(B0, 1, 0); PG8_LDB(B1, 1, 1); PG8_SCHED; PG8_LDA(At, 1, 0); PG8_STAGE(PG8_SA(0, 1), a2, voffA[1]);
            PG8_WAIT_V(8); PG8_WAIT_L(0); PG8_BAR; PG8_MMA(0, 0, At, B0); PG8_MMA(0, 1, At, B1); PG8_BAR; PG8_SCHED;
            PG8_LDA(At, 1, 1); PG8_STAGE(PG8_SB(1, 0), b3, voffB); PG8_STAGE(PG8_SB(1, 1), b3 + hstep, voffB); PG8_STAGE(PG8_SA(1, 0), a3, voffA[0]);
            PG8_WAIT_V(8); PG8_WAIT_L(0); PG8_BAR; PG8_MMA(1, 0, At, B0); PG8_MMA(1, 1, At, B1); PG8_BAR; PG8_SCHED;
        }
        if (wr == 0) PG8_BAR;
        E(acc, cur, wr, wc, fr, fq);
        if constexpr (EPI2) { asm volatile("" ::: "memory"); E(acc, cur, wr, wc, fr, fq); }
        if (!has_next) break;
#pragma unroll
        for (int a = 0; a < 2; ++a)
#pragma unroll
            for (int b = 0; b < 2; ++b)
#pragma unroll
                for (int m = 0; m < 4; ++m)
#pragma unroll
                    for (int n = 0; n < 2; ++n) acc[a][b][m][n] = (f32x4){0.f, 0.f, 0.f, 0.f};
        cur = nxt; cA = nA; cB = nB; ++ui;
        if (wr == 1) PG8_BAR;
    }
    PG8_WAIT_V(0);
    PG8_BAR;
#undef PG8_SA
#undef PG8_SB
#undef PG8_STAGE
#undef PG8_LDA
#undef PG8_LDB
#undef PG8_MMA
#undef PG8_WAIT_V
#undef PG8_WAIT_L
#undef PG8_BAR
#undef PG8_SCHED
#undef PG8_GATHER_OFFS
#undef PG8_WAIT_VR
}
}

struct EpiInProj {
    static constexpr bool PERM = true; static constexpr int NVM = 0; static constexpr int SC0 = 0x7F7F7F7F, SC1 = 0x7F7F7F7F;
    bf16_t* Z; const float* bias; float us;
    template <int MODE>
    __device__ __forceinline__ void plain(const f32x4 (&acc)[2][2][4][2], const pg8::GUnit& u, int wr, int wc, int fr, int fq) const {
        const int row0 = u.orow + wr * 64 + fr; const int cw = u.pn * 256 + wc * 32 + 8 * fq;
        f32x4 bb0[2], bb1[2];
#pragma unroll
        for (int bj = 0; bj < 2; ++bj) { bb0[bj] = *(const f32x4*)(bias + cw + bj * 128); bb1[bj] = *(const f32x4*)(bias + cw + bj * 128 + 4); }
#pragma unroll
        for (int bj = 0; bj < 2; ++bj) {
            const f32x4 b0 = bb0[bj], b1 = bb1[bj];
#pragma unroll
            for (int ai = 0; ai < 2; ++ai)
#pragma unroll
                for (int m = 0; m < 4; ++m) { f32x4 v0 = acc[ai][bj][m][0] * us + b0, v1 = acc[ai][bj][m][1] * us + b1;
                    if (MODE == 0) {
#pragma unroll
                        for (int j = 0; j < 4; ++j) { v0[j] = gelu_tanh_f(v0[j]); v1[j] = gelu_tanh_f(v1[j]); }
                    } else if (MODE == 1) { v0 = v0 * QSCALE; v1 = v1 * QSCALE; }
                    u32x4 w; w.x = cvtpk(v0[0], v0[1]); w.y = cvtpk(v0[2], v0[3]); w.z = cvtpk(v1[0], v1[1]); w.w = cvtpk(v1[2], v1[3]);
                    st16_wt(Z, (unsigned)(((row0 + ai * 128 + m * 16) * ZW + cw + bj * 128) * 2), w); }
            asm volatile("" ::: "memory");
        }
    }
    __device__ __forceinline__ void glu(const f32x4 (&acc)[2][2][4][2], const pg8::GUnit& u, int wr, int wc, int fr, int fq) const {
        const int row0 = u.orow + wr * 64 + fr; const int h0 = (u.pn - 5) * 128 + wc * 32 + 8 * fq;
        const f32x4 ba0 = *(const f32x4*)(bias + 1280 + h0), ba1 = *(const f32x4*)(bias + 1280 + h0 + 4), bg0 = *(const f32x4*)(bias + 1536 + h0), bg1 = *(const f32x4*)(bias + 1536 + h0 + 4);
#pragma unroll
        for (int ai = 0; ai < 2; ++ai)
#pragma unroll
            for (int m = 0; m < 4; ++m) {
                const f32x4 a0 = acc[ai][0][m][0] * us + ba0, a1 = acc[ai][0][m][1] * us + ba1, g0 = acc[ai][1][m][0] * us + bg0, g1 = acc[ai][1][m][1] * us + bg1;
                f32x4 y0, y1;
#pragma unroll
                for (int j = 0; j < 4; ++j) { y0[j] = a0[j] * sigmoid_f(g0[j]); y1[j] = a1[j] * sigmoid_f(g1[j]); }
                u32x4 w; w.x = cvtpk(y0[0], y0[1]); w.y = cvtpk(y0[2], y0[3]); w.z = cvtpk(y1[0], y1[1]); w.w = cvtpk(y1[2], y1[3]);
                st16_wt(Z, (unsigned)(((row0 + ai * 128 + m * 16) * ZW + 1280 + h0) * 2), w); }
    }
    __device__ __forceinline__ void operator()(const f32x4 (&acc)[2][2][4][2], const pg8::GUnit& u, int wr, int wc, int fr, int fq) const {
        const int pn = u.pn;
        if (pn < 2) plain<0>(acc, u, wr, wc, fr, fq); else if (pn < 4) plain<1>(acc, u, wr, wc, fr, fq); else if (pn == 4) plain<2>(acc, u, wr, wc, fr, fq); else glu(acc, u, wr, wc, fr, fq);
    }
};
struct EpiOutProj {
    static constexpr bool PERM = true; static constexpr int NVM = 0; static constexpr int SC0 = 0x7F7F7F7F, SC1 = 0x7F7F7F7F;
    bf16_t* R; const float* xf; const bf16_t* xb; const float* bias; const float* gmod;
    __device__ __forceinline__ void operator()(const f32x4 (&acc)[2][2][4][2], const pg8::GUnit& u, int wr, int wc, int fr, int fq) const {
        const int row0 = u.orow + wr * 64 + fr, col0 = u.pn * 256 + wc * 32 + 8 * fq; const int b = u.orow >> 12; constexpr float US = 1.0f / (S_YC8 * S_W8);
        if (xf) {
#pragma unroll
            for (int bj = 0; bj < 2; ++bj) { const int c = col0 + bj * 128;
                const f32x4 b0 = *(const f32x4*)(bias + c), b1 = *(const f32x4*)(bias + c + 4), g0 = *(const f32x4*)(gmod + b * 6144 + c) + 1.0f, g1 = *(const f32x4*)(gmod + b * 6144 + c + 4) + 1.0f;
                f32x4 x0[2][4], x1[2][4];
#pragma unroll
                for (int ai = 0; ai < 2; ++ai)
#pragma unroll
                    for (int m = 0; m < 4; ++m) { const unsigned vo = (unsigned)((row0 * DM + c) * 4), so = (unsigned)((ai * 128 + m * 16) * DM * 4); x0[ai][m] = __builtin_bit_cast(f32x4, ld16_buf(xf, vo, so)); x1[ai][m] = __builtin_bit_cast(f32x4, ld16_buf(xf, vo + 16, so)); }
#pragma unroll
                for (int ai = 0; ai < 2; ++ai)
#pragma unroll
                    for (int m = 0; m < 4; ++m) { const size_t off = (size_t)(row0 + ai * 128 + m * 16) * DM + c;
                        const f32x4 r0 = x0[ai][m] * ALPHA + g0 * (acc[ai][bj][m][0] * US + b0), r1 = x1[ai][m] * ALPHA + g1 * (acc[ai][bj][m][1] * US + b1);
                        u32x4 o; o.x = cvtpk(r0[0], r0[1]); o.y = cvtpk(r0[2], r0[3]); o.z = cvtpk(r1[0], r1[1]); o.w = cvtpk(r1[2], r1[3]);
                        st16_wt(R, (unsigned)(off * 2), o); }
                asm volatile("" ::: "memory"); }
        } else { u32x4 w[2][2][4]; f32x4 pb[2][4];
#pragma unroll
            for (int bj = 0; bj < 2; ++bj) { const int c = col0 + bj * 128;
                pb[bj][0] = *(const f32x4*)(bias + c); pb[bj][1] = *(const f32x4*)(bias + c + 4); pb[bj][2] = *(const f32x4*)(gmod + b * 6144 + c) + 1.0f; pb[bj][3] = *(const f32x4*)(gmod + b * 6144 + c + 4) + 1.0f;
#pragma unroll
                for (int ai = 0; ai < 2; ++ai)
#pragma unroll
                    for (int m = 0; m < 4; ++m) w[bj][ai][m] = ld16_buf(xb, (unsigned)((row0 * DM + c) * 2), (unsigned)((ai * 128 + m * 16) * DM * 2)); }
#pragma unroll
            for (int bj = 0; bj < 2; ++bj) { const int c = col0 + bj * 128;
#pragma unroll
                for (int ai = 0; ai < 2; ++ai)
#pragma unroll
                    for (int m = 0; m < 4; ++m) { const size_t off = (size_t)(row0 + ai * 128 + m * 16) * DM + c; const u32x4 ww = w[bj][ai][m];
                        const f32x4 x0 = (f32x4){bf_lo(ww.x), bf_hi(ww.x), bf_lo(ww.y), bf_hi(ww.y)}, x1 = (f32x4){bf_lo(ww.z), bf_hi(ww.z), bf_lo(ww.w), bf_hi(ww.w)};
                        const f32x4 r0 = x0 * ALPHA + pb[bj][2] * (acc[ai][bj][m][0] * US + pb[bj][0]), r1 = x1 * ALPHA + pb[bj][3] * (acc[ai][bj][m][1] * US + pb[bj][1]);
                        u32x4 o; o.x = cvtpk(r0[0], r0[1]); o.y = cvtpk(r0[2], r0[3]); o.z = cvtpk(r1[0], r1[1]); o.w = cvtpk(r1[2], r1[3]);
                        st16_wt(R, (unsigned)(off * 2), o); } }
            asm volatile("" ::: "memory"); }
    }
};
struct EpiGateUp {
    static constexpr bool PERM = true; static constexpr int NVM = 4; static constexpr int SC0 = 0x73737373, SC1 = 0x76767676;
    unsigned char* ACT;
    __device__ __forceinline__ void operator()(const f32x4 (&acc)[2][2][4][2], const pg8::GUnit& u, int wr, int wc, int fr, int fq) const {
        const int row0 = u.orow + wr * 64 + fr; const int c0 = u.pn * 128 + wc * 32 + 8 * fq;
        static_assert(S_H8 * S_W8 == 4096.f && S_ACT8 == 8.f, "gate/up MFMA scale bytes");
#pragma unroll
        for (int ai = 0; ai < 2; ++ai)
#pragma unroll
            for (int mp = 0; mp < 4; mp += 2) { u32x2 w[2];
#pragma unroll
                for (int t = 0; t < 2; ++t) { const int m = mp + t; f32x4 y[2];
#pragma unroll
                    for (int n = 0; n < 2; ++n) { const f32x4 g = acc[ai][0][m][n], up = acc[ai][1][m][n];
#pragma unroll
                        for (int j = 0; j < 4; ++j) y[n][j] = silu_f(g[j]) * up[j]; }
                    w[t].x = cvt4_fp8(y[0][0], y[0][1], y[0][2], y[0][3]); w[t].y = cvt4_fp8(y[1][0], y[1][1], y[1][2], y[1][3]); }
                const auto r0 = __builtin_amdgcn_permlane16_swap(w[0].x, w[1].x, false, false), r1 = __builtin_amdgcn_permlane16_swap(w[0].y, w[1].y, false, false);
                st16_wt(ACT, (unsigned)((row0 + ai * 128 + (mp + (fq & 1)) * 16) * DE + (c0 - 8 * (fq & 1))), (u32x4){r0[0], r1[0], r0[1], r1[1]}); }
    }
};
struct EpiDown {
    static constexpr bool PERM = true; static constexpr int NVM = 8; static constexpr int SC0 = 0x79797979, SC1 = 0x79797979;
    unsigned char* YE;
    __device__ __forceinline__ void operator()(const f32x4 (&acc)[2][2][4][2], const pg8::GUnit& u, int wr, int wc, int fr, int fq) const {
        const int row0 = u.orow + wr * 64 + fr; const int c0 = u.pn * 256 + wc * 32 + 8 * fq;
        static_assert(S_Y8 * 64.f == S_ACT8 * S_W8, "down MFMA scale byte");
#pragma unroll
        for (int ai = 0; ai < 2; ++ai)
#pragma unroll
            for (int mp = 0; mp < 4; mp += 2) { const unsigned rowp = (unsigned)((row0 + ai * 128 + (mp + (fq & 1)) * 16) * DM + (c0 - 8 * (fq & 1)));
#pragma unroll
                for (int bj = 0; bj < 2; ++bj) { u32x2 w[2];
#pragma unroll
                    for (int t = 0; t < 2; ++t) { const f32x4 v0 = acc[ai][bj][mp + t][0], v1 = acc[ai][bj][mp + t][1];
                        w[t].x = cvt4_fp8(v0[0], v0[1], v0[2], v0[3]); w[t].y = cvt4_fp8(v1[0], v1[1], v1[2], v1[3]); }
                    const auto r0 = __builtin_amdgcn_permlane16_swap(w[0].x, w[1].x, false, false), r1 = __builtin_amdgcn_permlane16_swap(w[0].y, w[1].y, false, false);
                    st16_wt(YE, rowp + bj * 128, (u32x4){r0[0], r1[0], r0[1], r1[1]}); } }
    }
};

struct MoeOrder {
    const char* Abase; const char* Wbase; size_t wstride; int rowbytes; int vcu; int ntile; const LAS int* ue; bool gather;
    __device__ __forceinline__ bool next(int i, pg8::GUnit& u) const {
        if (i >= 8) return false;
        const int Lu = i * 256 + vcu; const int tile = Lu >> 2, pn = Lu & 3; const int e = __builtin_amdgcn_readfirstlane(ue[i]);
        if (e < 0) return false;
        u.A = gather ? Abase : Abase + (size_t)tile * 256 * rowbytes; u.B = Wbase + (size_t)e * wstride + (size_t)pn * 256 * rowbytes;
        u.orow = tile * 256; u.pn = pn; u.aux = e; u.tokoff = i * 1024; return true;
    }
};

#define XB_TMO      128
#define XB_XCNT(j)  (256  + 64 * (j))
#define XB_XSUB(j)  (1280 + 64 * (j))
#define XB_XGEN(j)  (2304 + 64 * (j))
#define XB_TOP      3328
#define XB_TOPGEN   3392
#define XCD_BAR_WORDS 3456
#define XB_SPIN_CAP (1u << 20)
__device__ __forceinline__ unsigned xb_ld(unsigned* p)              { return __hip_atomic_load(p, __ATOMIC_RELAXED, __HIP_MEMORY_SCOPE_AGENT); }
__device__ __forceinline__ unsigned xb_add(unsigned* p, unsigned v) { return __hip_atomic_fetch_add(p, v, __ATOMIC_RELAXED, __HIP_MEMORY_SCOPE_AGENT); }
__device__ __forceinline__ unsigned xb_xcc_id() { return (unsigned)__builtin_amdgcn_s_getreg((3 << 11) | 20) & 0xFu; }
#define XB_SPIN(cond, bar) do { unsigned _sp = 0; while (cond) { __builtin_amdgcn_s_sleep(1); \
    if ((++_sp & 255u) == 0u) { if (xb_ld(&(bar)[XB_TMO])) break; if (_sp > XB_SPIN_CAP) { atomicAdd(&(bar)[XB_TMO], 1u); break; } } } } while (0)
struct XcdBarrier { unsigned* bar; unsigned x; volatile LAS unsigned* st; };
__device__ __forceinline__ XcdBarrier xcd_barrier_post(unsigned* bar, volatile LAS unsigned* st) {
    XcdBarrier b; b.bar = bar; b.x = xb_xcc_id(); b.st = st;
    if (threadIdx.x == 0) (void)xb_add(&bar[XB_XCNT(b.x)], 1u);
    return b;
}
__device__ __forceinline__ void xcd_barrier_complete(unsigned* bar, unsigned x, unsigned& nloc, unsigned& nx) {
    const unsigned G = gridDim.x * gridDim.y * gridDim.z;
    unsigned sum, cnt, mine, sp = 0u;
    for (;;) {
        sum = 0u; cnt = 0u; mine = 0u;
#pragma unroll
        for (unsigned j = 0; j < 16; ++j) { const unsigned c = xb_ld(&bar[XB_XCNT(j)]); sum += c; cnt += (c > 0u) ? 1u : 0u; mine = (j == x) ? c : mine; }
        if (sum == G) break;
        __builtin_amdgcn_s_sleep(1);
        if ((++sp & 255u) == 0u) { if (xb_ld(&bar[XB_TMO])) break; if (sp > XB_SPIN_CAP) { atomicAdd(&bar[XB_TMO], 1u); break; } }
    }
    nloc = mine > 0u ? mine : 1u; nx = cnt > 0u ? cnt : 1u;
}
__device__ __forceinline__ void xcd_barrier(const XcdBarrier& b) {
    asm volatile("s_waitcnt vmcnt(0)" ::: "memory");
    __syncthreads();
    if (phase_tid() == 0) {
        unsigned* bar = b.bar; asm volatile("" : "+s"(bar));
        const unsigned bxc = xb_xcc_id();
        __builtin_amdgcn_s_waitcnt(0);
        unsigned nloc = b.st[0], nx = b.st[1];
        if (nloc == 0u) { xcd_barrier_complete(bar, bxc, nloc, nx); b.st[0] = nloc; b.st[1] = nx; }
        const unsigned old = xb_add(&bar[XB_XSUB(bxc)], 1u);
        const unsigned gen = old / nloc;
        if (old + 1u == (gen + 1u) * nloc) {
            __builtin_amdgcn_fence(__ATOMIC_RELEASE, "agent");
            asm volatile("s_waitcnt vmcnt(0)" ::: "memory");
            const unsigned og = xb_add(&bar[XB_TOP], 1u);
            const unsigned tg = og / nx;
            if (og + 1u == (tg + 1u) * nx) xb_add(&bar[XB_TOPGEN], 1u);
            else XB_SPIN(xb_ld(&bar[XB_TOPGEN]) == tg, bar);
            __builtin_amdgcn_fence(__ATOMIC_ACQUIRE, "agent");
            asm volatile("s_waitcnt vmcnt(0)" ::: "memory");
        } else {
            XB_SPIN(xb_ld(&bar[XB_TOPGEN]) == gen, bar);
            __builtin_amdgcn_fence(__ATOMIC_ACQUIRE, "agent");
            asm volatile("s_waitcnt vmcnt(0)" ::: "memory");
        }
    }
    __syncthreads();
}

struct Params {
    const float* in[27];
    float* out;
    unsigned char* ws;
    int ph_lo, ph_hi;
    int use_bar, never;
};
enum { I_X = 0, I_C, I_ADAW, I_ADAB, I_WIN, I_BIN, I_GLNG, I_GLNB, I_GWS, I_GBS, I_SINK, I_CONVW, I_CONVB, I_CLNG, I_CLNB, I_WOUT, I_BOUT, I_LMG, I_LMB,
       I_WGATE, I_WUP, I_WDOWN, I_LFG, I_LFB, I_RELB, I_RW, I_RB };

template <bool FP8>
__device__ __forceinline__ void transpose_item(const float* W, int N, int k0, int n0, unsigned char* dst0, int ldk, float scale, LAS float* scr, int lane, const unsigned char* wsbase) {
    { const int cq = (lane & 15) * 4, kr = lane >> 4;
      f32x4 v[16];
#pragma unroll
      for (int i = 0; i < 16; ++i) v[i] = *(const f32x4*)(W + (size_t)(k0 + 4 * i + kr) * N + n0 + cq);
#pragma unroll
      for (int i = 0; i < 16; ++i) { LAS float* p = scr + (4 * i + kr) * 65 + cq; p[0] = v[i][0]; p[1] = v[i][1]; p[2] = v[i][2]; p[3] = v[i][3]; } }
    LDS_WAIT(); asm volatile("" ::: "memory");
    if (FP8) { const int c = lane & 3;
#pragma unroll
        for (int j = 0; j < 4; ++j) { const int n = (lane >> 2) + 16 * j; const LAS float* s = scr + (16 * c) * 65 + n; u32x4 o;
#pragma unroll
            for (int q = 0; q < 4; ++q) o[q] = cvt4_fp8(s[(4 * q) * 65] * scale, s[(4 * q + 1) * 65] * scale, s[(4 * q + 2) * 65] * scale, s[(4 * q + 3) * 65] * scale);
            st16_wt(wsbase, (unsigned)(dst0 - wsbase) + (unsigned)(n * ldk + k0 + 16 * c), o); }
        LDS_WAIT(); asm volatile("" ::: "memory"); return; }
    const int c = lane & 7;
#pragma unroll
    for (int j = 0; j < 8; ++j) { const int n = (lane >> 3) + 8 * j; const LAS float* s = scr + (8 * c) * 65 + n;
        if (FP8) { }
        else { u32x4 o; o.x = cvtpk(s[0 * 65], s[1 * 65]); o.y = cvtpk(s[2 * 65], s[3 * 65]); o.z = cvtpk(s[4 * 65], s[5 * 65]); o.w = cvtpk(s[6 * 65], s[7 * 65]);
            *(u32x4*)(dst0 + ((size_t)n * ldk + k0 + 8 * c) * 2) = o; } }
    LDS_WAIT(); asm volatile("" ::: "memory");
}

__device__ __forceinline__ void convert_weights(const Params& P, int l, LAS unsigned char* lds, int gw, int NGW, int wave, int lane, int it_first = -1, int it_stride = 0, int it_last = 0, bool do_wsb = true) {
    LAS float* scr = (LAS float*)(lds + wave * 16640);
    unsigned char* ws = P.ws;
    unsigned char* Win = ws + WS_WIN; unsigned char* Wout = ws + WS_WOUT; unsigned char* Wgu = ws + ((l & 1) ? WS_WGU1 : WS_WGU); unsigned char* Wd = ws + ((l & 1) ? WS_WD1 : WS_WD);
    constexpr int I_IN = 16 * 28, I_OUT = 16 * 16, I_E = 32 * 128;
    constexpr int NITEMS = I_IN + I_OUT + 3 * I_E;
    if (it_first < 0) { it_first = gw; it_stride = NGW; it_last = NITEMS; }
    for (int it = it_first; it < it_last; it += it_stride) {
        int r = it;
        if (r < 2 * I_E) { const int up = r / I_E; r -= up * I_E; const int e = r >> 7, q = r & 127, kb = q >> 3, nb = q & 7, n0 = nb * 64;
            const float* src = (up ? P.in[I_WUP] : P.in[I_WGATE]) + ((size_t)l * NE + e) * DM * DE;
            const int dr = 256 * (n0 >> 7) + (n0 & 127) + (up ? 128 : 0);
            transpose_item<true>(src, DE, kb * 64, n0, Wgu + ((size_t)e * 1024 + dr) * DM, DM, S_W8, scr, lane, ws); continue; }
        r -= 2 * I_E;
        if (r < I_E) { const int e = r >> 7, q = r & 127, kb = q >> 4, nb = q & 15;
            transpose_item<true>(P.in[I_WDOWN] + ((size_t)l * NE + e) * DE * DM, DM, kb * 64, nb * 64, Wd + ((size_t)e * 1024 + nb * 64) * DE, DE, S_W8, scr, lane, ws); continue; }
        r -= I_E;
        if (r < I_IN) { const int kb = r / 28, nb = r % 28, n0 = nb * 64; int dr;
            if (n0 < 1280) dr = n0; else if (n0 < 1536) { const int j = n0 - 1280; dr = 1280 + 256 * (j >> 7) + (j & 127); } else { const int j = n0 - 1536; dr = 1280 + 256 * (j >> 7) + 128 + (j & 127); }
            transpose_item<true>(P.in[I_WIN] + (size_t)l * DM * INW, INW, kb * 64, n0, Win + (size_t)dr * DM, DM, S_W8, scr, lane, ws); continue; }
        r -= I_IN;
        { const int kb = r / 16, nb = r % 16; transpose_item<true>(P.in[I_WOUT] + (size_t)l * DM * DM, DM, kb * 64, nb * 64, Wout + (size_t)(nb * 64) * DM, DM, S_W8, scr, lane, ws); }
    }
    if (!do_wsb) return;
    bf16_t* wsb = (bf16_t*)(ws + WS_WSB); const float* gws = P.in[I_GWS] + (size_t)l * 4 * 128 * 128;
    for (int i = gw * 64 + lane; i < 4 * 128 * 128 / 2; i += NGW * 64) { const f32x2 v = *(const f32x2*)(gws + 2 * i); ((unsigned*)wsb)[i] = cvtpk(v.x, v.y); }
}

__device__ __forceinline__ void phase_prep(const Params& P, LAS unsigned char* lds, int vcu, int G) {
    const int tid = phase_tid(), lane = tid & 63, wave = __builtin_amdgcn_readfirstlane(tid >> 6);
    float* mod = (float*)(P.ws + WS_MOD);
    if (vcu < 96) {
        LAS float* sc = (LAS float*)lds;
        LAS float* red = (LAS float*)(lds + 32768);
        for (int i = tid; i < 8192; i += 512) sc[i] = silu_f(P.in[I_C][i]);
        __syncthreads();
        const int l = vcu / 48, rem = vcu % 48, cc = rem >> 1, dh = rem & 1; const int col = cc * 256 + 4 * lane; const int d0 = dh * 512 + wave * 64;
        const float* w = P.in[I_ADAW] + ((size_t)l * DM + d0) * 6144 + col;
        f32x4 a[8];
#pragma unroll
        for (int bq = 0; bq < 8; ++bq) a[bq] = (f32x4){0.f, 0.f, 0.f, 0.f};
#pragma unroll 1
        for (int dq = 0; dq < 64; dq += 8) {
            f32x4 wv[8];
            const float* wq = w + (size_t)dq * 6144;
#pragma unroll
            for (int i = 0; i < 8; ++i) wv[i] = *(const f32x4*)(wq + (size_t)i * 6144);
#pragma unroll
            for (int i = 0; i < 8; ++i)
#pragma unroll
                for (int bq = 0; bq < 8; ++bq) a[bq] += wv[i] * sc[bq * 1024 + d0 + dq + i];
        }
#pragma unroll
        for (int bq = 0; bq < 8; ++bq) *(LAS f32x4*)(red + (wave * 8 + bq) * 256 + 4 * lane) = a[bq];
        __syncthreads();
        for (int o = tid; o < 8 * 256; o += 512) { const int bq = o >> 8, cl = o & 255; float sum = 0.f;
#pragma unroll
            for (int w8 = 0; w8 < 8; ++w8) sum += red[(w8 * 8 + bq) * 256 + cl];
            if (dh == 0) sum += P.in[I_ADAB][l * 6144 + cc * 256 + cl];
            atomicAdd(mod + ((size_t)l * 8 + bq) * 6144 + cc * 256 + cl, sum); }
        __syncthreads();
    }
    if (vcu == (G > 200 ? 200 : 0)) {
        float* bt = (float*)(P.ws + WS_BTAB);
        for (int i = tid; i < 8 * 4 * 320; i += 512) { const int h = i / (4 * 320), rem = i % (4 * 320), sft = rem / 320, j = rem % 320; const int idx = j + sft - 32; float v = -1.0e30f;
            if (idx >= 0 && idx <= 256) { const int rel = idx - 128; const int n = rel < 0 ? -rel : rel; int bk;
                if (n < 8) bk = n; else if (n < 12) bk = 8; else if (n < 16) bk = 9; else if (n < 23) bk = 10; else if (n < 32) bk = 11; else if (n < 46) bk = 12; else if (n < 64) bk = 13; else if (n < 91) bk = 14; else bk = 15;
                if (rel > 0) bk += 16;
                v = P.in[I_RELB][bk * 8 + h] * LOG2E; }
            bt[i] = v; }
    }
    __syncthreads();
    if (G == 256) { constexpr int NIT = 16 * 28 + 16 * 16 + 3 * 32 * 128;
        if (vcu < 96) convert_weights(P, 0, lds, vcu * 8 + wave, G * 8, wave, lane, 4096 + vcu * 8 + wave, 96 * 8, 4096 + 768, false);
        else { convert_weights(P, 0, lds, vcu * 8 + wave, G * 8, wave, lane, 4096 + 768 + (vcu - 96) * 8 + wave, 160 * 8, 8192, false);
               convert_weights(P, 0, lds, vcu * 8 + wave, G * 8, wave, lane, 12288 + (vcu - 96) * 8 + wave, 160 * 8, NIT, false); }
        convert_weights(P, 0, lds, vcu * 8 + wave, G * 8, wave, lane, 0, 1, 0, true); }
    else convert_weights(P, 0, lds, vcu * 8 + wave, G * 8, wave, lane);
}

__device__ __forceinline__ void phase_h0(const Params& P, int vcu, int G) {
    const int tid = phase_tid(), lane = tid & 63, wave = tid >> 6;
    const float* mod = (const float*)(P.ws + WS_MOD); unsigned char* H = P.ws + WS_H;
#ifdef FP8_SELFCHECK
    if (vcu == 0 && tid == 0) { const float big = 1000.f + 0.f * mod[0]; const unsigned tv = cvt4_fp8(big, -big, 460.f, 448.f);
        if (tv != 0x7E7EFE7Eu) ((float*)(P.ws + WS_MOD))[2048] = __builtin_nanf(""); }
#endif
#pragma unroll 1
    for (int ch = vcu * 8 + wave; ch * 16 < NT; ch += G * 8) {
        const int mb = ch * 16, b = mb >> 12; const float* sh = mod + (size_t)b * 6144;
        f32x4 psc[4], psh[4];
#pragma unroll
        for (int j = 0; j < 4; ++j) { const int c = RCOL(lane, j); psc[j] = *(const f32x4*)(sh + 1024 + c) + 1.0f; psh[j] = *(const f32x4*)(sh + c); }
#pragma unroll 1
        for (int q = 0; q < 2; ++q) {
            f32x4 x[8][4];
#pragma unroll
            for (int i = 0; i < 8; ++i)
#pragma unroll
                for (int j = 0; j < 4; ++j) x[i][j] = *(const f32x4*)(P.in[I_X] + (size_t)(mb + 8 * q + i) * DM + RCOL(lane, j));
#pragma unroll
            for (int i = 0; i < 8; ++i) { u32x4 hw;
#pragma unroll
                for (int j = 0; j < 4; ++j) { const f32x4 h = (x[i][j] * psc[j] + psh[j]) * S_H8; hw[j] = cvt4_fp8(h[0], h[1], h[2], h[3]); }
                st16_wt(H, (unsigned)((mb + 8 * q + i) * DM + 16 * lane), hw); }
        }
    }
}

__device__ __forceinline__ int crow(int r, int hi) { return (r & 3) + 8 * (r >> 2) + 4 * hi; }
__device__ __forceinline__ s16x4 tr_read(const LAS unsigned char* p) { return __builtin_bit_cast(s16x4, __builtin_amdgcn_ds_read_tr16_b64_v4i16((LAS v4i16_t*)p)); }

constexpr int AT_KS = 144, AT_VS = 128, AT_KOFF = 0, AT_VOFF = 384 * AT_KS, AT_BOFF = AT_VOFF + 384 * AT_VS, AT_TS = 320;
static_assert(384 * 144 + 384 * 128 + 8 * 4 * 320 * 4 <= LDS_MISC, "attention LDS map must stay below the barrier words");
constexpr float AT_THR = 8.0f;
struct KVRegs { u32x4 k[6], v[6]; };
template <bool DO_K, bool DO_V>
__device__ __forceinline__ void attn_kv_load(const bf16_t* Z, int b, int n, int kvh, int, KVRegs& r) {
    const int tid = phase_tid();
    const long tok0 = (long)b * SEQ + (long)(n - 1) * 128;
#pragma unroll
    for (int i = 0; i < 6; ++i) { const int c = tid + 512 * i, row = c >> 3, ch = c & 7, blk = n - 1 + (row >> 7);
        if (DO_K) r.k[i] = (u32x4){0u, 0u, 0u, 0u}; if (DO_V) r.v[i] = (u32x4){0u, 0u, 0u, 0u};
        if (blk >= 0 && blk < 32) { const bf16_t* src = Z + (size_t)(tok0 + row) * ZW + 1024 + kvh * 64 + ch * 8; if (DO_K) r.k[i] = *(const u32x4*)src; if (DO_V) r.v[i] = *(const u32x4*)(src + 128); } }
}
__device__ __forceinline__ void attn_kv_store(LAS unsigned char* lds, int, const KVRegs& r) {
    const int tid = phase_tid();
#pragma unroll
    for (int i = 0; i < 6; ++i) { const int c = tid + 512 * i, row = c >> 3, ch = c & 7;
        *(LAS u32x4*)(lds + AT_KOFF + row * AT_KS + ch * 16) = r.k[i]; *(LAS u32x4*)(lds + AT_VOFF + row * AT_VS + ch * 16) = r.v[i]; }
}
__device__ __forceinline__ void attn_tables(const float* btab, int tid, LAS unsigned char* lds) {
    static_assert(AT_TS == 320 && 8 * 4 * AT_TS * 4 == 5 * 512 * 16, "table image: 2560 sixteen-byte pieces");
    u32x4 v[5];
#pragma unroll
    for (int k = 0; k < 5; ++k) v[k] = *(const u32x4*)(btab + 4 * (tid + 512 * k));
#pragma unroll
    for (int k = 0; k < 5; ++k) *(LAS u32x4*)(lds + AT_BOFF + 16 * (tid + 512 * k)) = v[k];
}
template <class F>
__device__ __forceinline__ void attn_compute(const bf16_t* Z, unsigned char* Y, const float* sink, int b, int n, int kvh, LAS unsigned char* lds, F&& prefetch) {
    const int tid = phase_tid(), lane = tid & 63, wid = __builtin_amdgcn_readfirstlane(tid >> 6), r32 = lane & 31, hi = lane >> 5;
    const int hh = wid >> 1, qh = wid & 1, head = kvh * 4 + hh;
    const LAS float* bt = (const LAS float*)(lds + AT_BOFF);
    const float sk = sink[head] * LOG2E;
#pragma unroll 1
    for (int rb = 0; rb < 2; ++rb) {
        const int qb = 2 * qh + rb; const int iq = 32 * qb + r32;
        const size_t qtok = (size_t)b * SEQ + (size_t)n * 128 + iq;
        bf16x8 qf[4];
#pragma unroll
        for (int ks = 0; ks < 4; ++ks) qf[ks] = *(const bf16x8*)(Z + qtok * ZW + 512 + head * 64 + 16 * ks + 8 * hi);
        if (rb == 0) prefetch();
        float mrun = sk, lrun = hi ? 0.f : 1.0f; f32x16 o0 = {}, o1 = {};
#pragma unroll 1
        for (int kb = 0; kb < 3; ++kb) {
            const int blk = n - 1 + kb; if (blk < 0 || blk >= 32) continue;
            const int kt_lo = (kb == 0) ? qb : 0, kt_hi = (kb == 2) ? qb : 3;
#define AT_QK(P_, KROW_) do { const int i0_ = (KROW_) - iq + 4 * hi + 32; const int sft_ = i0_ & 3; const LAS float* bp_ = bt + (head * 4 + sft_) * AT_TS + (i0_ - sft_); \
                _Pragma("unroll") for (int g4 = 0; g4 < 4; ++g4) { const f32x4 bv = *(const LAS f32x4*)(bp_ + 8 * g4); _Pragma("unroll") for (int t = 0; t < 4; ++t) P_[4 * g4 + t] = bv[t] - mrun; } \
                _Pragma("unroll") for (int ks = 0; ks < 4; ++ks) { const bf16x8 kf = *(const LAS bf16x8*)(lds + AT_KOFF + ((KROW_) + r32) * AT_KS + (16 * ks + 8 * hi) * 2); \
                    P_ = __builtin_amdgcn_mfma_f32_32x32x16_bf16(kf, qf[ks], P_, 0, 0, 0); } } while (0)
#define AT_EXP(P_, RS_) do { RS_ = 0.f; _Pragma("unroll") for (int r = 0; r < 16; ++r) { const float e = fast_exp2(P_[r]); P_[r] = e; RS_ += e; } } while (0)
#define AT_PV(P_, KROW_) do { u32x4 pw0, pw1; \
                pw0.x = cvtpk(P_[0], P_[1]); pw0.y = cvtpk(P_[2], P_[3]); pw0.z = cvtpk(P_[4], P_[5]); pw0.w = cvtpk(P_[6], P_[7]); \
                pw1.x = cvtpk(P_[8], P_[9]); pw1.y = cvtpk(P_[10], P_[11]); pw1.z = cvtpk(P_[12], P_[13]); pw1.w = cvtpk(P_[14], P_[15]); \
                const LAS unsigned char* vb = lds + AT_VOFF + ((KROW_) + 4 * hi + ((lane & 15) >> 2)) * AT_VS + (16 * ((lane >> 4) & 1) + 4 * (lane & 3)) * 2; \
                _Pragma("unroll") for (int s2 = 0; s2 < 2; ++s2) { const bf16x8 pf = __builtin_bit_cast(bf16x8, s2 == 0 ? pw0 : pw1); \
                    _Pragma("unroll") for (int db = 0; db < 2; ++db) { \
                        const s16x4 lo = tr_read(vb + (16 * s2) * AT_VS + db * 64), hv = tr_read(vb + (16 * s2 + 8) * AT_VS + db * 64); \
                        const bf16x8 vf = {lo[0], lo[1], lo[2], lo[3], hv[0], hv[1], hv[2], hv[3]}; \
                        if (db == 0) o0 = __builtin_amdgcn_mfma_f32_32x32x16_bf16(vf, pf, o0, 0, 0, 0); else o1 = __builtin_amdgcn_mfma_f32_32x32x16_bf16(vf, pf, o1, 0, 0, 0); } } } while (0)
#define AT_CAREFUL(P_, KROW_) do { AT_QK(P_, KROW_); \
                float mx = fmaxf(fmaxf(P_[0], P_[1]), fmaxf(P_[2], P_[3])); \
                _Pragma("unroll") for (int r = 4; r < 16; r += 4) mx = fmaxf(mx, fmaxf(fmaxf(P_[r], P_[r + 1]), fmaxf(P_[r + 2], P_[r + 3]))); \
                mx = max_halves(mx); const float d = fmaxf(mx, 0.f), f = fast_exp2(-d); mrun += d; lrun *= f; float rs_ = 0.f; \
                _Pragma("unroll") for (int r = 0; r < 16; ++r) { const float e = fast_exp2(P_[r] - d); P_[r] = e; rs_ += e; o0[r] *= f; o1[r] *= f; } \
                lrun += rs_; AT_PV(P_, KROW_); } while (0)
            int kt = kt_lo;
#pragma unroll 1
            for (; kt + 1 <= kt_hi; kt += 2) {
                const int krow = kb * 128 + kt * 32;
                f32x16 pa, pb; float rsa, rsb;
                AT_QK(pa, krow); AT_QK(pb, krow + 32);
                AT_EXP(pa, rsa); AT_EXP(pb, rsb);
                if (__any(!(rsa + rsb < 65536.0f))) { AT_CAREFUL(pa, krow); AT_CAREFUL(pb, krow + 32); }
                else { lrun += rsa + rsb; AT_PV(pa, krow); AT_PV(pb, krow + 32); }
            }
            if (kt <= kt_hi) {
                const int krow = kb * 128 + kt * 32;
                f32x16 pa; float rsa;
                AT_QK(pa, krow); AT_EXP(pa, rsa);
                if (__any(!(rsa < 65536.0f))) { AT_CAREFUL(pa, krow); }
                else { lrun += rsa; AT_PV(pa, krow); }
            }
#undef AT_QK
#undef AT_EXP
#undef AT_PV
#undef AT_CAREFUL
        }
        lrun = sum_halves(lrun);
        const float inv = 1.0f / lrun;
        unsigned char* yo = Y + qtok * DM + 256 + head * 64; const float inv8 = inv * S_YC8;
#pragma unroll
        for (int g4 = 0; g4 < 4; ++g4) {
            *(unsigned*)(yo + 8 * g4 + 4 * hi) = cvt4_fp8(o0[4 * g4] * inv8, o0[4 * g4 + 1] * inv8, o0[4 * g4 + 2] * inv8, o0[4 * g4 + 3] * inv8);
            *(unsigned*)(yo + 32 + 8 * g4 + 4 * hi) = cvt4_fp8(o1[4 * g4] * inv8, o1[4 * g4 + 1] * inv8, o1[4 * g4 + 2] * inv8, o1[4 * g4 + 3] * inv8); }
    }
}

constexpr int GM_VS = 544;
struct GmRegs { u32x2 v[16]; bf16x8 wf[4][4]; };
__device__ __forceinline__ void gm_load(const bf16_t* Z, size_t tokbase, int, int, GmRegs& r) {
    const int tid = phase_tid(), lane = tid & 63, wid = tid >> 6;
#pragma unroll
    for (int i = 0; i < 16; ++i) r.v[i] = *(const u32x2*)(Z + (tokbase + wid * 16 + i) * ZW + 256 + 4 * lane);
}
__device__ __forceinline__ void gm_load_ws(const Params& P, int, int, GmRegs& r) {
    const int tid = phase_tid(), lane = tid & 63, wid = tid >> 6;
    const int hh = wid >> 1, ph = wid & 1, fr = lane & 15, fq = lane >> 4;
    const bf16_t* wsb = (const bf16_t*)(P.ws + WS_WSB) + (size_t)hh * 128 * 128;
#pragma unroll
    for (int ks = 0; ks < 4; ++ks)
#pragma unroll
        for (int pt = 0; pt < 4; ++pt) r.wf[ks][pt] = *(const bf16x8*)(wsb + (size_t)(ph * 64 + pt * 16 + fr) * 128 + ks * 32 + 8 * fq);
}
__device__ __forceinline__ void gm_ln_store(const Params& P, int l, int, int, const GmRegs& r, LAS unsigned char* lds) {
    const int tid = phase_tid(), lane = tid & 63, wid = tid >> 6;
    const f32x4 g = *(const f32x4*)(P.in[I_GLNG] + l * 256 + 4 * lane), be = *(const f32x4*)(P.in[I_GLNB] + l * 256 + 4 * lane);
#pragma unroll
    for (int i = 0; i < 16; ++i) { const int t = wid * 16 + i; const u32x2 w = r.v[i];
        f32x4 v = {bf_lo(w.x), bf_hi(w.x), bf_lo(w.y), bf_hi(w.y)};
        const float mean = wave_sum((v[0] + v[1]) + (v[2] + v[3])) * (1.f / 256.f); v = v - mean;
        const float var = wave_sum((v[0] * v[0] + v[1] * v[1]) + (v[2] * v[2] + v[3] * v[3])) * (1.f / 256.f);
        const float rstd = __builtin_amdgcn_rsqf(var + LN_EPS); v = v * rstd * g + be;
        u32x2 o; o.x = cvtpk(v[0], v[1]); o.y = cvtpk(v[2], v[3]); *(LAS u32x2*)(lds + t * GM_VS + 8 * lane) = o; }
}
__device__ __forceinline__ void gm_mfma(const Params& P, int l, const bf16_t* Z, unsigned char* Y, size_t tokbase, int, int, const GmRegs& r, LAS unsigned char* lds) {
    const int tid = phase_tid(), lane = tid & 63, wid = tid >> 6;
    const int hh = wid >> 1, ph = wid & 1, fr = lane & 15, fq = lane >> 4;
    u32x2 uw[4][4];
#pragma unroll
    for (int pt = 0; pt < 4; ++pt)
#pragma unroll
        for (int dt = 0; dt < 4; ++dt) uw[pt][dt] = *(const u32x2*)(Z + (tokbase + ph * 64 + pt * 16 + fr) * ZW + hh * 64 + 16 * dt + 4 * fq);
    f32x4 acc[4][4];
#pragma unroll
    for (int dt = 0; dt < 4; ++dt)
#pragma unroll
        for (int pt = 0; pt < 4; ++pt) acc[dt][pt] = (f32x4){0.f, 0.f, 0.f, 0.f};
#pragma unroll
    for (int ks = 0; ks < 4; ++ks) {
        const LAS unsigned char* vb = lds + (ks * 32 + 8 * fq + (fr >> 2)) * GM_VS + (hh * 64 + 4 * (fr & 3)) * 2;
#pragma unroll
        for (int dt = 0; dt < 4; ++dt) { const s16x4 lo = tr_read(vb + dt * 32), hv = tr_read(vb + 4 * GM_VS + dt * 32);
            const bf16x8 vf = {lo[0], lo[1], lo[2], lo[3], hv[0], hv[1], hv[2], hv[3]};
#pragma unroll
            for (int pt = 0; pt < 4; ++pt) acc[dt][pt] = __builtin_amdgcn_mfma_f32_16x16x32_bf16(vf, r.wf[ks][pt], acc[dt][pt], 0, 0, 0); }
    }
    const float* bs = P.in[I_GBS] + l * 512 + hh * 128;
#pragma unroll
    for (int pt = 0; pt < 4; ++pt) { const int p = ph * 64 + pt * 16 + fr; const float bsv = bs[p];
#pragma unroll
        for (int dt = 0; dt < 4; ++dt) { const int c = hh * 64 + 16 * dt + 4 * fq; const u32x2 u2 = uw[pt][dt];
            const f32x4 a = (acc[dt][pt] + bsv) * S_YC8;
            *(unsigned*)(Y + (tokbase + p) * DM + c) = cvt4_fp8(bf_lo(u2.x) * a[0], bf_hi(u2.x) * a[1], bf_lo(u2.y) * a[2], bf_hi(u2.y) * a[3]); } }
}
struct CvRegs { u32x4 c[6]; };
__device__ __forceinline__ void cv_load(const bf16_t* Z, int b, int n, int hf, int, CvRegs& r) {
    const int tid = phase_tid();
    const int s0 = n * 128 + hf * 64;
#pragma unroll
    for (int i = 0; i < 6; ++i) { const int c = tid + 512 * i, row = c >> 5, ch = c & 31; const int sq = s0 - 15 + row; r.c[i] = (u32x4){0u, 0u, 0u, 0u};
        if (row < 94 && sq >= 0 && sq < SEQ) r.c[i] = *(const u32x4*)(Z + ((size_t)b * SEQ + sq) * ZW + 1280 + ch * 8); }
}
__device__ __forceinline__ void cv_store(LAS unsigned char* lds, int, const CvRegs& r) {
    const int tid = phase_tid();
#pragma unroll
    for (int i = 0; i < 6; ++i) { const int c = tid + 512 * i, row = c >> 5, ch = c & 31; const u32x4 v = r.c[i];
        if (row < 94) { *(LAS f32x4*)(lds + row * 1024 + ch * 32) = (f32x4){bf_lo(v.x), bf_hi(v.x), bf_lo(v.y), bf_hi(v.y)};
            *(LAS f32x4*)(lds + row * 1024 + ch * 32 + 16) = (f32x4){bf_lo(v.z), bf_hi(v.z), bf_lo(v.w), bf_hi(v.w)}; } }
}
__device__ __forceinline__ void cv_compute(const f32x4 (&cw)[31], f32x4 cb, f32x4 g, f32x4 be, unsigned char* Y, size_t tok0, int, int, LAS unsigned char* lds) {
    const int tid = phase_tid(), lane = tid & 63, wid = tid >> 6;
#pragma unroll 1
    for (int pr = 0; pr < 4; ++pr) { const int t = wid * 8 + 2 * pr; f32x4 a0 = cb, a1 = cb;
        const LAS unsigned char* yp = lds + t * 1024 + 16 * lane;
        f32x4 yq[8];
#pragma unroll
        for (int r = 0; r < 8; ++r) yq[r] = *(const LAS f32x4*)(yp + r * 1024);
        __builtin_amdgcn_sched_barrier(0);
#pragma unroll
        for (int r4 = 0; r4 < 32; r4 += 4) {
            f32x4 yc[4];
#pragma unroll
            for (int k = 0; k < 4; ++k) yc[k] = yq[(r4 + k) & 7];
#pragma unroll
            for (int k = 0; k < 4; ++k) if (r4 + k + 8 < 32) yq[(r4 + k) & 7] = *(const LAS f32x4*)(yp + (r4 + k + 8) * 1024);
#pragma unroll
            for (int k = 0; k < 4; ++k) { const int r = r4 + k;
                if (r < 31) a0 += yc[k] * cw[r];
                if (r > 0) a1 += yc[k] * cw[r - 1]; }
            __builtin_amdgcn_sched_barrier(0);
        }
#pragma unroll
        for (int i = 0; i < 2; ++i) { f32x4 a = i ? a1 : a0;
            const float mean = wave_sum((a[0] + a[1]) + (a[2] + a[3])) * (1.f / 256.f); a = a - mean;
            const float var = wave_sum((a[0] * a[0] + a[1] * a[1]) + (a[2] * a[2] + a[3] * a[3])) * (1.f / 256.f);
            const float rstd = __builtin_amdgcn_rsqf(var + LN_EPS); a = a * rstd * g + be;
            *(unsigned*)(Y + (tok0 + t + i) * DM + 768 + 4 * lane) = cvt4_fp8(silu_f(a[0]) * S_YC8, silu_f(a[1]) * S_YC8, silu_f(a[2]) * S_YC8, silu_f(a[3]) * S_YC8); } }
}

__device__ __forceinline__ void phase_mixers(const Params& P, int l, LAS unsigned char* lds, int vcu, int G) {
    const bf16_t* Z = (const bf16_t*)(P.ws + WS_Z); unsigned char* Y = P.ws + WS_YCAT;
    const float* sink = P.in[I_SINK] + l * 8;
    const int tid = phase_tid(), lane = tid & 63, wid = __builtin_amdgcn_readfirstlane(tid >> 6);
    bool tables_done = false;
#pragma unroll 1
    for (int u = vcu; u < NB * 32; u += G) { const int b = u >> 5, n = u & 31; const size_t tokbase = (size_t)b * SEQ + (size_t)n * 128;
        {
        { KVRegs kv; attn_kv_load<true, true>(Z, b, n, 0, tid, kv);
          if (!tables_done) { attn_tables((const float*)(P.ws + WS_BTAB), tid, lds); tables_done = true; }
          attn_kv_store(lds, tid, kv); }
        __syncthreads();
        { attn_compute(Z, Y, sink, b, n, 0, lds, [&]() {});
          KVRegs kv; attn_kv_load<true, true>(Z, b, n, 1, tid, kv);
          __syncthreads();
          attn_kv_store(lds, tid, kv); }
        __syncthreads();
        }
        attn_compute(Z, Y, sink, b, n, 1, lds, [&]() {});
        GmRegs gm; gm_load(Z, tokbase, wid, lane, gm);
        __syncthreads();
        {
        gm_load_ws(P, wid, lane, gm);
        gm_ln_store(P, l, wid, lane, gm, lds);
        CvRegs cv; cv_load(Z, b, n, 0, tid, cv);
        __syncthreads();
        gm_mfma(P, l, Z, Y, tokbase, wid, lane, gm, lds);
        __syncthreads();
        cv_store(lds, tid, cv);
        f32x4 cw[31]; f32x4 cb, g, be;
        { const int lane2 = phase_tid() & 63; const float* cwp = P.in[I_CONVW] + (size_t)l * 31 * 256 + 4 * lane2;
#pragma unroll
          for (int w = 0; w < 31; ++w) cw[w] = *(const f32x4*)(cwp + w * 256);
          cb = *(const f32x4*)(P.in[I_CONVB] + l * 256 + 4 * lane2); g = *(const f32x4*)(P.in[I_CLNG] + l * 256 + 4 * lane2); be = *(const f32x4*)(P.in[I_CLNB] + l * 256 + 4 * lane2); }
        cv_load(Z, b, n, 1, tid, cv);
        __syncthreads();
        cv_compute(cw, cb, g, be, Y, tokbase, wid, lane, lds);
        __syncthreads();
        cv_store(lds, tid, cv);
        __syncthreads();
        cv_compute(cw, cb, g, be, Y, tokbase + 64, wid, lane, lds);
        __syncthreads();
        }
    }
}

__device__ __forceinline__ void moe_table(const Params& P, int l, LAS unsigned char* lds, int vcu) {
    LAS int* ts = (LAS int*)(lds + LDS_TS); LAS int* cn = (LAS int*)(lds + LDS_TS + 256); LAS int* ue = (LAS int*)(lds + LDS_TS + 384);
    const int tidm = phase_tid();
    if (tidm < 64) { const int lane = tidm; unsigned* cw = (unsigned*)(P.ws + WS_CTL) + CW_CNT + 2048 * l;
        const int c = lane < NE ? (int)__hip_atomic_load(cw + 64 * lane, __ATOMIC_RELAXED, __HIP_MEMORY_SCOPE_AGENT) : 0;
        const int nt = (c + 255) >> 8; int incl = nt;
#pragma unroll
        for (int o = 1; o < 32; o <<= 1) { const int v = __builtin_amdgcn_ds_bpermute(((lane - o) & 63) << 2, incl); if ((lane & 31) >= o) incl += v; }
        if (lane < NE) { ts[lane] = incl - nt; cn[lane] = c; }
        if (lane == NE - 1) ts[NE] = incl; }
    __syncthreads();
    { const int lane = tidm & 63, i = tidm >> 6;
      const int tile = (i * 256 + vcu) >> 2; const bool le = lane >= 1 && lane < NE && ts[lane] <= tile;
      const unsigned long long mk = __ballot(le);
      if (lane == 0) ue[i] = tile < ts[NE] ? __popcll(mk) : -1; }
    __syncthreads();
}

constexpr int LA_RS = 2064;
constexpr int LA_HI = 0, LA_PART = 32 * LA_RS, LA_HIST = LA_PART + 8 * 32 * 32 * 4, LA_BASE = LA_HIST + 128, LA_REC = LA_HIST + 256;
__device__ __forceinline__ void phase_ln_a(const Params& P, int l, LAS unsigned char* lds, int vcu, int G, bool dry = false) {
    const int tid = phase_tid(), lane = tid & 63, wave = __builtin_amdgcn_readfirstlane(tid >> 6), r32 = lane & 31, hi = lane >> 5;
    LAS int* hist = (LAS int*)(lds + LA_HIST); LAS int* basel = (LAS int*)(lds + LA_BASE); LAS int* rec = (LAS int*)(lds + LA_REC);
    LAS float* part = (LAS float*)(lds + LA_PART);
    if (tid < 32) hist[tid] = 0;
    bf16x8 bhi[8], blo[8];
    { const float* rw = P.in[I_RW];
#pragma unroll
      for (int ks = 0; ks < 8; ++ks) { u32x4 hw, lw;
#pragma unroll
          for (int jp = 0; jp < 4; ++jp) { const int k = 128 * wave + 16 * ks + 8 * hi + 2 * jp; const float w0 = rw[(size_t)k * 32 + r32], w1 = rw[(size_t)(k + 1) * 32 + r32];
              const unsigned h = cvtpk(w0, w1); const unsigned lo = cvtpk(w0 - bf_lo(h), w1 - bf_hi(h)); hw[jp] = h; lw[jp] = lo; }
          bhi[ks] = __builtin_bit_cast(bf16x8, hw); blo[ks] = __builtin_bit_cast(bf16x8, lw); } }
    const bf16_t* R = (const bf16_t*)(P.ws + WS_R); unsigned char* H8 = P.ws + WS_H8;
    const float* mod = (const float*)(P.ws + WS_MOD) + (size_t)l * 8 * 6144;
    const float* lg = P.in[I_LMG] + l * DM; const float* lb = P.in[I_LMB] + l * DM;
    unsigned* cntw = (unsigned*)(P.ws + WS_CTL) + CW_CNT + 2048 * (dry ? 2 + l : l);
    int* list = (int*)(P.ws + WS_LIST); int* rinfo = (int*)(P.ws + WS_RINFO); float* rgate = (float*)(P.ws + WS_RGATE);
    const float rbias = P.in[I_RB][lane & 31];
    __syncthreads();
#pragma unroll 1
    for (int blk = vcu; blk * 128 < NT; blk += G) {
        const int mb = blk * 128;
        f32x4 plg[4], plb[4], psc[4], psh[4];
        { const int bb = mb >> 12; const float* shb = mod + (size_t)bb * 6144 + 3072;
#pragma unroll
          for (int j = 0; j < 4; ++j) { const int c = RCOL(lane, j); plg[j] = *(const f32x4*)(lg + c); plb[j] = *(const f32x4*)(lb + c); psc[j] = *(const f32x4*)(shb + 1024 + c) + 1.0f; psh[j] = *(const f32x4*)(shb + c); } }
        u32x4 vn[4][2];
#pragma unroll
        for (int i = 0; i < 4; ++i)
#pragma unroll
            for (int j = 0; j < 2; ++j) vn[i][j] = *(const u32x4*)(R + (size_t)(mb + 4 * wave + i) * DM + 16 * lane + 8 * j);
#pragma unroll 1
        for (int rd = 0; rd < 4; ++rd) {
#pragma unroll
            for (int ip = 0; ip < 2; ++ip) {
                f32x4 v[2][4];
#pragma unroll
                for (int i = 0; i < 2; ++i)
#pragma unroll
                    for (int j = 0; j < 4; ++j) { const u32x4 w4 = vn[2 * ip + i][j >> 1]; const unsigned wx_ = w4[2 * (j & 1)], wy_ = w4[2 * (j & 1) + 1]; v[i][j] = (f32x4){bf_lo(wx_), bf_hi(wx_), bf_lo(wy_), bf_hi(wy_)}; }
                if (rd < 3) {
#pragma unroll
                    for (int i = 0; i < 2; ++i)
#pragma unroll
                        for (int j = 0; j < 2; ++j) vn[2 * ip + i][j] = *(const u32x4*)(R + (size_t)(mb + 32 * (rd + 1) + 4 * wave + 2 * ip + i) * DM + 16 * lane + 8 * j);
                }
#pragma unroll
                for (int i = 0; i < 2; ++i) {
                    const int lr = 4 * wave + 2 * ip + i; const int m = mb + 32 * rd + lr;
                    float s = 0.f;
#pragma unroll
                    for (int j = 0; j < 4; ++j) s += (v[i][j][0] + v[i][j][1]) + (v[i][j][2] + v[i][j][3]);
                    const float mean = wave_sum(s) * (1.f / DM); float s2 = 0.f;
#pragma unroll
                    for (int j = 0; j < 4; ++j) { v[i][j] = v[i][j] - mean; s2 += (v[i][j][0] * v[i][j][0] + v[i][j][1] * v[i][j][1]) + (v[i][j][2] * v[i][j][2] + v[i][j][3] * v[i][j][3]); }
                    const float rstd = __builtin_amdgcn_rsqf(wave_sum(s2) * (1.f / DM) + LN_EPS);
                    if (lane == 0) *(f32x2*)((float*)(P.ws + WS_STATS) + 2 * m) = (f32x2){mean, rstd};
                    u32x4 wha, whb, h8;
#pragma unroll
                    for (int j = 0; j < 4; ++j) { const f32x4 x1 = v[i][j] * rstd * plg[j] + plb[j];
                        const f32x4 h = x1 * psc[j] + psh[j];
                        const unsigned h_lo = cvtpk(h[0], h[1]), h_hi = cvtpk(h[2], h[3]);
                        if (j < 2) { wha[2 * j] = h_lo; wha[2 * j + 1] = h_hi; } else { whb[2 * j - 4] = h_lo; whb[2 * j - 3] = h_hi; }
                        h8[j] = cvt4_fp8(h[0] * S_H8, h[1] * S_H8, h[2] * S_H8, h[3] * S_H8); }
                    st16_wt(H8, (unsigned)(m * DM + 16 * lane), h8);
                    *(LAS u32x4*)(lds + LA_HI + lr * LA_RS + 32 * lane) = wha; *(LAS u32x4*)(lds + LA_HI + lr * LA_RS + 32 * lane + 16) = whb;
                }
            }
            __syncthreads();
            { f32x16 acc = {};
#pragma unroll
              for (int ks = 0; ks < 8; ++ks) { const bf16x8 ah = *(const LAS bf16x8*)(lds + LA_HI + r32 * LA_RS + (128 * wave + 16 * ks + 8 * hi) * 2);
                  acc = __builtin_amdgcn_mfma_f32_32x32x16_bf16(ah, bhi[ks], acc, 0, 0, 0); acc = __builtin_amdgcn_mfma_f32_32x32x16_bf16(ah, blo[ks], acc, 0, 0, 0); }
#pragma unroll
              for (int r = 0; r < 16; ++r) part[(wave * 32 + crow(r, hi)) * 32 + r32] = acc[r]; }
            __syncthreads();
#pragma unroll
            for (int ps = 0; ps < 2; ++ps) {
                const int lr = 4 * wave + 2 * ps + hi; const int m = mb + 32 * rd + lr; const int e = lane & 31;
                float logit = 0.f;
#pragma unroll
                for (int w8 = 0; w8 < 8; ++w8) logit += part[(w8 * 32 + lr) * 32 + e];
                const float score = 1.0f / (1.0f + __expf(-logit)); const float sel = score + rbias;
                int rank = 0;
#define RANK_STEP(J) { const float o = xlane_f<J>(sel, lane); const int oe = e ^ J; rank += (o > sel || (o == sel && oe < e)) ? 1 : 0; }
                RANK_STEP(1) RANK_STEP(2) RANK_STEP(3) RANK_STEP(4) RANK_STEP(5) RANK_STEP(6) RANK_STEP(7)
#undef RANK_STEP
                float gs = rank < 2 ? sel : 0.f; gs += xlane_f<1>(gs, lane); gs += xlane_f<2>(gs, lane); gs += xlane_f<7>(gs, lane);
                float bgs = gs; int bg = e >> 3;
                { const float ogs = xlane_f<8>(bgs, lane); const int og = xlane_i<8>(bg, lane); if (ogs > bgs || (ogs == bgs && og < bg)) { bgs = ogs; bg = og; } }
                { const float ogs = xlane_f<16>(bgs, lane); const int og = xlane_i<16>(bg, lane); if (ogs > bgs || (ogs == bgs && og < bg)) { bgs = ogs; bg = og; } }
                const unsigned long long mk0 = __ballot((e >> 3) == bg && rank == 0), mk1 = __ballot((e >> 3) == bg && rank == 1);
                const unsigned h0m = hi ? (unsigned)(mk0 >> 32) : (unsigned)mk0, h1m = hi ? (unsigned)(mk1 >> 32) : (unsigned)mk1;
                const int e0 = __ffs(h0m) - 1, e1 = __ffs(h1m) - 1;
                const float sc0 = __shfl(score, 32 * hi + e0), sc1 = __shfl(score, 32 * hi + e1);
                if (e == 0) { const float inv = 1.0f / (sc0 + sc1);
                    const int q0 = __hip_atomic_fetch_add(hist + e0, 1, __ATOMIC_RELAXED, __HIP_MEMORY_SCOPE_WORKGROUP);
                    const int q1 = __hip_atomic_fetch_add(hist + e1, 1, __ATOMIC_RELAXED, __HIP_MEMORY_SCOPE_WORKGROUP);
                    LAS int* rp = rec + (32 * rd + lr) * 4; rp[0] = e0; rp[1] = q0; rp[2] = e1; rp[3] = q1;
                    if (!dry) { rgate[2 * m] = sc0 * inv; rgate[2 * m + 1] = sc1 * inv; } }
            }
        }
        __syncthreads();
        if (tid < 32) { const int c = hist[tid]; basel[tid] = c ? (int)__hip_atomic_fetch_add(cntw + 64 * tid, (unsigned)c, __ATOMIC_RELAXED, __HIP_MEMORY_SCOPE_AGENT) : 0; hist[tid] = 0; }
        __syncthreads();
        if (tid < 128 && !dry) { const int m = mb + tid; const LAS int* rp = rec + tid * 4; const int e0 = rp[0], p0 = basel[e0] + rp[1], e1 = rp[2], p1 = basel[e1] + rp[3];
            list[(size_t)e0 * 65536 + p0] = m; list[(size_t)e1 * 65536 + p1] = m;
            *(int4*)(rinfo + 4 * m) = make_int4(e0, p0, e1, p1); }
        __syncthreads();
    }
}

__device__ __forceinline__ void phase_ln_b(const Params& P, int l, LAS unsigned char* lds, int vcu, int G) {
    const int tid = phase_tid(), lane = tid & 63, wave = tid >> 6;
    if (!MK_ONE_LAUNCH) moe_table(P, l, lds, vcu);
    const LAS int* ts = (const LAS int*)(lds + LDS_TS);
    const bf16_t* X1 = (const bf16_t*)(P.ws + WS_R); const unsigned char* YE = P.ws + WS_YE; unsigned char* H = P.ws + WS_H; bf16_t* XB = (bf16_t*)(P.ws + WS_XB);
    const float* lmg = P.in[I_LMG] + l * DM; const float* lmb = P.in[I_LMB] + l * DM;
    const float* mod = (const float*)(P.ws + WS_MOD) + (size_t)l * 8 * 6144; const float* modn = (const float*)(P.ws + WS_MOD) + (size_t)(l + 1) * 8 * 6144;
    const float* lg = P.in[I_LFG] + l * DM; const float* lb = P.in[I_LFB] + l * DM;
    const int* rinfo = (const int*)(P.ws + WS_RINFO); const float* rgate = (const float*)(P.ws + WS_RGATE); const float* stats = (const float*)(P.ws + WS_STATS);
    { LAS float* pl = (LAS float*)lds; for (int i = tid; i < DM; i += 512) { pl[i] = lmg[i] * ALPHA; pl[DM + i] = lmb[i] * ALPHA; } }
    __syncthreads();
#pragma unroll 1
    for (int ch = vcu * 8 + wave; ch * 16 < NT; ch += G * 8) {
        const int mb = ch * 16;
        f32x4 pg2[4], plg[4], plb[4], psc[4], psh[4];
        { const int bb = mb >> 12;
#pragma unroll
          for (int j = 0; j < 4; ++j) { const int c = RCOL(lane, j); pg2[j] = *(const f32x4*)(mod + (size_t)bb * 6144 + 5120 + c) + 1.0f; plg[j] = *(const f32x4*)(lg + c); plb[j] = *(const f32x4*)(lb + c);
              if (l + 1 < NL) { psc[j] = *(const f32x4*)(modn + (size_t)bb * 6144 + 1024 + c) + 1.0f; psh[j] = *(const f32x4*)(modn + (size_t)bb * 6144 + c); } else { psc[j] = plg[j]; psh[j] = plb[j]; } } }
        int sA = 0, sB = 0; float gA = 0.f, gB = 0.f, mu = 0.f, rs = 0.f;
        if (lane < 16) { const int4 ri = *(const int4*)(rinfo + 4 * (mb + lane)); const f32x2 rg = *(const f32x2*)(rgate + 2 * (mb + lane)); const f32x2 st = *(const f32x2*)(stats + 2 * (mb + lane));
            sA = ts[ri.x] * 256 + ri.y; sB = ts[ri.z] * 256 + ri.w; gA = rg.x * (1.0f / S_Y8); gB = rg.y * (1.0f / S_Y8); mu = st.x; rs = st.y; }
        u32x4 nx[2][2], mx2[2][2], na[2], nb[2], ma[2], mb2[2];
#define LNB_LOAD(pr, nx, na, nb) do { _Pragma("unroll") for (int i = 0; i < 2; ++i) { const int rr_ = 2 * (pr) + i; const int sa_ = __builtin_amdgcn_readlane(sA, rr_), sb_ = __builtin_amdgcn_readlane(sB, rr_); \
            const unsigned char* ya_ = YE + (size_t)sa_ * DM; const unsigned char* yb_ = YE + (size_t)sb_ * DM; const bf16_t* xr_ = X1 + (size_t)(mb + rr_) * DM; \
            nx[i][0] = *(const u32x4*)(xr_ + 16 * lane); nx[i][1] = *(const u32x4*)(xr_ + 16 * lane + 8); na[i] = *(const u32x4*)(ya_ + 16 * lane); nb[i] = *(const u32x4*)(yb_ + 16 * lane); } } while (0)
        LNB_LOAD(0, nx, na, nb); LNB_LOAD(1, mx2, ma, mb2);
#pragma unroll 1
        for (int pr = 0; pr < 8; ++pr) {
            u32x4 x[2][2], wa[2], wb[2];
#pragma unroll
            for (int i = 0; i < 2; ++i) { x[i][0] = nx[i][0]; x[i][1] = nx[i][1]; wa[i] = na[i]; wb[i] = nb[i]; nx[i][0] = mx2[i][0]; nx[i][1] = mx2[i][1]; na[i] = ma[i]; nb[i] = mb2[i]; }
            if (pr < 6) LNB_LOAD(pr + 2, mx2, ma, mb2);
#pragma unroll
            for (int i = 0; i < 2; ++i) {
                const int rr = 2 * pr + i; const int m = mb + rr;
                const float ga = __builtin_bit_cast(float, __builtin_amdgcn_readlane(__builtin_bit_cast(int, gA), rr)), gb = __builtin_bit_cast(float, __builtin_amdgcn_readlane(__builtin_bit_cast(int, gB), rr));
                f32x4 v[4]; float s = 0.f;
                const float rstd0 = __builtin_bit_cast(float, __builtin_amdgcn_readlane(__builtin_bit_cast(int, rs), rr)), c0 = -__builtin_bit_cast(float, __builtin_amdgcn_readlane(__builtin_bit_cast(int, mu), rr)) * rstd0;
#pragma unroll
                for (int j = 0; j < 4; ++j) { const unsigned xl_ = x[i][j >> 1][2 * (j & 1)], xh_ = x[i][j >> 1][2 * (j & 1) + 1];
                    const f32x4 gmA = *(const LAS f32x4*)(lds + (16 * lane + 4 * j) * 4), bmA = *(const LAS f32x4*)(lds + 4096 + (16 * lane + 4 * j) * 4);
                    v[j] = ((f32x4){bf_lo(xl_), bf_hi(xl_), bf_lo(xh_), bf_hi(xh_)} * rstd0 + c0) * gmA + bmA;
                    __builtin_amdgcn_sched_barrier(0); }
#pragma unroll
                for (int j = 0; j < 4; ++j) {
                    const f32x2 a01 = __builtin_amdgcn_cvt_pk_f32_fp8((int)wa[i][j], false), a23 = __builtin_amdgcn_cvt_pk_f32_fp8((int)wa[i][j], true), b01 = __builtin_amdgcn_cvt_pk_f32_fp8((int)wb[i][j], false), b23 = __builtin_amdgcn_cvt_pk_f32_fp8((int)wb[i][j], true);
                    const f32x4 y = (f32x4){a01.x, a01.y, a23.x, a23.y} * ga + (f32x4){b01.x, b01.y, b23.x, b23.y} * gb;
                    v[j] = v[j] + pg2[j] * y; s += (v[j][0] + v[j][1]) + (v[j][2] + v[j][3]); }
                const float mean = wave_sum(s) * (1.f / DM); float s2 = 0.f;
#pragma unroll
                for (int j = 0; j < 4; ++j) { v[j] = v[j] - mean; s2 += (v[j][0] * v[j][0] + v[j][1] * v[j][1]) + (v[j][2] * v[j][2] + v[j][3] * v[j][3]); }
                const float rstd = __builtin_amdgcn_rsqf(wave_sum(s2) * (1.f / DM) + LN_EPS);
                u32x4 wxa, wxb, h8;
#pragma unroll
                for (int j = 0; j < 4; ++j) { const f32x4 x2 = v[j] * rstd * plg[j] + plb[j];
                    if (l + 1 >= NL) st16_wt(P.out, (unsigned)((m * DM + 16 * lane + 4 * j) * 4), __builtin_bit_cast(u32x4, x2));
                    else { const unsigned x_lo = cvtpk(x2[0], x2[1]), x_hi = cvtpk(x2[2], x2[3]); if (j < 2) { wxa[2 * j] = x_lo; wxa[2 * j + 1] = x_hi; } else { wxb[2 * j - 4] = x_lo; wxb[2 * j - 3] = x_hi; }
                        const f32x4 h = (x2 * psc[j] + psh[j]) * S_H8; h8[j] = cvt4_fp8(h[0], h[1], h[2], h[3]); } }
                if (l + 1 < NL) { st16_wt(XB, (unsigned)((m * DM + 16 * lane) * 2), wxa); st16_wt(XB, (unsigned)((m * DM + 16 * lane) * 2 + 16), wxb); st16_wt(H, (unsigned)(m * DM + 16 * lane), h8); }
            }
        }
#undef LNB_LOAD
    }
    __syncthreads();
    if (l + 1 < NL) { if (G == 256) { convert_weights(P, l + 1, lds, vcu * 8 + wave, G * 8, wave, lane, 7168 + vcu * 8 + wave, G * 8, 8192, false);
            convert_weights(P, l + 1, lds, vcu * 8 + wave, G * 8, wave, lane, 12288 + vcu * 8 + wave, G * 8, 16 * 28 + 16 * 16 + 3 * 32 * 128, true); }
        else convert_weights(P, l + 1, lds, vcu * 8 + wave, G * 8, wave, lane); }
}

template <bool GATEUP>
__device__ __forceinline__ void phase_moe(const Params& P, int l, LAS unsigned char* lds, int vcu, int G) {
    if (GATEUP || !MK_ONE_LAUNCH) moe_table(P, l, lds, vcu);
    const LAS int* ts = (const LAS int*)(lds + LDS_TS); const LAS int* cn = (const LAS int*)(lds + LDS_TS + 256); const LAS int* ue = (const LAS int*)(lds + LDS_TS + 384);
    MoeOrder S; S.vcu = vcu; S.ntile = ts[NE]; S.ue = ue;
    if (GATEUP) {
        const int* list = (const int*)(P.ws + WS_LIST); LAS int* tok = (LAS int*)(lds + LDS_TOK);
        for (int idx = phase_tid(); idx < 8 * 256; idx += 512) { const int i = idx >> 8, r = idx & 255; const int e = ue[i];
            if (e >= 0) { const int tile = (i * 256 + vcu) >> 2; const int rr = (tile - ts[e]) * 256 + r; tok[idx] = list[(size_t)e * 65536 + (rr < cn[e] ? rr : 0)]; } }
        __syncthreads();
        S.Abase = (const char*)(P.ws + WS_H8); S.Wbase = (const char*)(P.ws + ((l & 1) ? WS_WGU1 : WS_WGU)); S.wstride = (size_t)1024 * 1024; S.rowbytes = DM; S.gather = true;
        EpiGateUp E{(unsigned char*)(P.ws + WS_ACT)};
        pg8::gemm_phase<EpiGateUp, MoeOrder, true, true, ((REP_MASK >> 12) & 1) != 0>(lds, lds + LDS_TOK, DM, S, E);
        if (SPARE_CONV && G == 256 && vcu >= 128) { const int tid_ = phase_tid(), w_ = tid_ >> 6; const int wi = (vcu - 128) * 8 + w_;
            convert_weights(P, l, lds, 0, 1, w_, tid_ & 63, 8192 + wi, 1024, 12288, false); }
    } else {
        { LAS int* tok = (LAS int*)(lds + LDS_TOK);
          for (int idx = phase_tid(); idx < 8 * 256; idx += 512) { const int i = idx >> 8, r = idx & 255; tok[idx] = (((i * 256 + vcu) >> 2) << 8) + r; }
          __syncthreads(); }
        S.Abase = (const char*)(P.ws + WS_ACT); S.Wbase = (const char*)(P.ws + ((l & 1) ? WS_WD1 : WS_WD)); S.wstride = (size_t)1024 * 512; S.rowbytes = DE; S.gather = true;
        EpiDown E{P.ws + WS_YE};
        pg8::gemm_phase<EpiDown, MoeOrder, true, true, ((REP_MASK >> 13) & 1) != 0>(lds, lds + LDS_TOK, DE, S, E);
        if (SPARE_CONV && G == 256 && l + 1 < NL && vcu >= 128) { const int tid_ = phase_tid(), w_ = tid_ >> 6; const int wi = (vcu - 128) * 8 + w_;
            convert_weights(P, l + 1, lds, 0, 1, w_, tid_ & 63, 4096 + wi, 1024, 7168, false); }
    }
}

constexpr int N_PHASES = 2 + 7 * NL;
__global__ void __launch_bounds__(512, 2) enc_fwd(Params P0) {
    extern __shared__ __attribute__((aligned(16))) unsigned char lds_raw[];
    LAS unsigned char* lds = (LAS unsigned char*)lds_raw;
    const int tid = threadIdx.x;
#if FP8_ASM_CLAMP
    asm volatile("s_setreg_imm32_b32 hwreg(HW_REG_MODE, 23, 1), 1");
#endif
    const int G = gridDim.x; const int bx = blockIdx.x; const int vcu = (G % 8 == 0) ? (bx % 8) * (G / 8) + bx / 8 : bx;
    const int G_ = G, bx_ = bx, vcu_ = vcu;
    volatile LAS unsigned* MISC = (volatile LAS unsigned*)(lds + LDS_MISC);
    if (tid < 32) MISC[tid] = 0u;
    __syncthreads();
    unsigned* ctl = (unsigned*)(P0.ws + WS_CTL);
    XcdBarrier bar; bar.bar = ctl + CW_BAR; bar.x = 0; bar.st = nullptr;
    if (P0.use_bar) bar = xcd_barrier_post(ctl + CW_BAR, MISC + 8);
    if (P0.never) cg::this_grid().sync();
#define SEAM(k) do { if (P0.use_bar && (k) + 1 < P0.ph_hi) { xcd_barrier(bar); if ((REP_MASK >> 11) & 1) { xcd_barrier(bar); xcd_barrier(bar); } } } while (0)
#ifndef PH_MASK
#define PH_MASK 0x1ff
#endif
#define PHK(k) ((k) < 2 ? (k) : 2 + ((k) - 2) % 7)
#define IN(k) (((PH_MASK >> PHK(k)) & 1) && P0.ph_lo <= (k) && (k) < P0.ph_hi)
#define REP(bit) ((REP_MASK >> (bit)) & 1)
#define RBAR() do { if (P0.use_bar) xcd_barrier(bar); } while (0)
    if (IN(0)) { phase_prep(P0, lds, vcu, G); if (REP(0)) { RBAR(); phase_prep(P0, lds, vcu, G); } SEAM(0); }
    if (IN(1)) { phase_h0(P0, vcu, G); if (REP(1)) { RBAR(); phase_h0(P0, vcu, G); } SEAM(1); }
#pragma unroll 1
    for (int l = 0; l < NL; ++l) {
        const int p0 = 2 + 7 * l;
        Params Q = P0; { GAS unsigned char* w_ = (GAS unsigned char*)P0.ws; GAS float* o_ = (GAS float*)P0.out; asm volatile("" : "+s"(w_), "+s"(o_)); Q.ws = (unsigned char*)w_; Q.out = (float*)o_; }
        const Params& P = Q;
        int bxl = bx_, vcul = vcu_, Gl = G_; asm volatile("" : "+s"(bxl), "+s"(vcul), "+s"(Gl));
        const int bx = bxl, vcu = vcul, G = Gl;
        if (IN(p0 + 0)) {
#pragma unroll 1
            for (int rep = 0; rep < 1 + REP(2); ++rep) { if (rep) RBAR();
            pg8::DenseOrder S; S.init(P.ws + WS_H, P.ws + WS_WIN, NT, INW, DM / 2, G, bx); S.gather = true;
            { LAS int* tok = (LAS int*)(lds + LDS_TOK); pg8::GUnit uu;
              for (int i = 0; i < 8 && S.next(i, uu); ++i) for (int r = phase_tid(); r < 256; r += 512) tok[i * 256 + r] = uu.orow + r;
              __syncthreads(); }
            EpiInProj E{(bf16_t*)(P.ws + WS_Z), P.in[I_BIN] + l * INW, 1.0f / (S_H8 * S_W8)};
            pg8::gemm_phase<EpiInProj, pg8::DenseOrder, true, true, ((REP_MASK >> 14) & 1) != 0>(lds, lds + LDS_TOK, DM, S, E);
            if (SPARE_CONV && G == 256 && !rep && bx >= 128) { const int tid_ = phase_tid(), w_ = tid_ >> 6; const int wi = (bx - 128) * 8 + w_;
                convert_weights(P, l, lds, 0, 1, w_, tid_ & 63, wi, 1024, 4096, false); } }
            SEAM(p0 + 0);
        }
        if (IN(p0 + 1)) {
#pragma unroll 1
            for (int rep = 0; rep < 1 + REP(3); ++rep) { if (rep) RBAR(); phase_mixers(P, l, lds, vcu, G); }
            SEAM(p0 + 1); }
        if (IN(p0 + 2)) {
#pragma unroll 1
            for (int rep = 0; rep < 1 + REP(4); ++rep) { if (rep) RBAR();
            pg8::DenseOrder S; S.init(P.ws + WS_YCAT, P.ws + WS_WOUT, NT, DM, DM / 2, G, bx); S.gather = true;
            { LAS int* tok = (LAS int*)(lds + LDS_TOK); pg8::GUnit uu;
              for (int i = 0; i < 8 && S.next(i, uu); ++i) for (int r = phase_tid(); r < 256; r += 512) tok[i * 256 + r] = uu.orow + r;
              __syncthreads(); }
            EpiOutProj E{(bf16_t*)(P.ws + WS_R), l == 0 ? P.in[I_X] : nullptr, (const bf16_t*)(P.ws + WS_XB), P.in[I_BOUT] + l * DM, (const float*)(P.ws + WS_MOD) + (size_t)l * 8 * 6144 + 2048};
            pg8::gemm_phase<EpiOutProj, pg8::DenseOrder, true, true>(lds, lds + LDS_TOK, DM, S, E); }
            SEAM(p0 + 2);
        }
        if (IN(p0 + 3)) {
#pragma unroll 1
            for (int rep = 0; rep < 1 + REP(5); ++rep) { if (rep) RBAR(); phase_ln_a(P, l, lds, vcu, G, rep != 0); }
            SEAM(p0 + 3); }
        if (IN(p0 + 4)) {
#pragma unroll 1
            for (int rep = 0; rep < 1 + REP(6); ++rep) { if (rep) RBAR(); phase_moe<true>(P, l, lds, vcu, G); }
            SEAM(p0 + 4); }
        if (IN(p0 + 5)) {
#pragma unroll 1
            for (int rep = 0; rep < 1 + REP(7); ++rep) { if (rep) RBAR(); phase_moe<false>(P, l, lds, vcu, G); }
            SEAM(p0 + 5); }
        if (IN(p0 + 6)) {
#pragma unroll 1
            for (int rep = 0; rep < 1 + REP(8); ++rep) { if (rep) RBAR(); phase_ln_b(P, l, lds, vcu, G); }
            SEAM(p0 + 6); }
    }
#undef SEAM
#undef IN
}

extern "C" void kernel_launch(void* const* d_in, const int* in_sizes, int n_in, void* d_out, int out_size, void* d_ws, size_t ws_size, hipStream_t stream) {
    static int grid = 0;
    if (grid == 0) {
        if (n_in != 27 || out_size != NT * DM || ws_size < WS_END) { fprintf(stderr, "kernel_launch: unexpected shapes (n_in %d out %d ws %zu)\n", n_in, out_size, ws_size); grid = -1; return; }
        int dev = 0, cus = 0, per_cu = 0;
        hipGetDevice(&dev); hipDeviceGetAttribute(&cus, hipDeviceAttributeMultiprocessorCount, dev);
        hipFuncSetAttribute((const void*)enc_fwd, hipFuncAttributeMaxDynamicSharedMemorySize, LDS_BYTES);
        hipOccupancyMaxActiveBlocksPerMultiprocessor(&per_cu, (const void*)enc_fwd, 512, LDS_BYTES);
        (void)hipGetLastError();
        if (per_cu < 1) { fprintf(stderr, "kernel_launch: occupancy query says %d blocks/CU\n", per_cu); per_cu = 1; }
        grid = cus;
        if (grid != 256) fprintf(stderr, "kernel_launch: note: %d CUs\n", grid);
    }
    if (grid < 0) return;
    hipMemsetAsync((char*)d_ws + WS_CTL, 0, CTL_BYTES, stream);
    Params p{};
    for (int i = 0; i < 27; ++i) p.in[i] = (const float*)d_in[i];
    p.out = (float*)d_out; p.ws = (unsigned char*)d_ws; p.never = 0;
#if MK_ONE_LAUNCH
    p.ph_lo = 0; p.ph_hi = N_PHASES; p.use_bar = 1;
    void* args[] = {&p};
    hipError_t e = hipLaunchCooperativeKernel((const void*)enc_fwd, dim3(grid), dim3(512), args, LDS_BYTES, stream);
    if (e != hipSuccess) fprintf(stderr, "cooperative launch failed: %s\n", hipGetErrorString(e));
#else
    for (int ph = 0; ph < N_PHASES; ++ph) { p.ph_lo = ph; p.ph_hi = ph + 1; p.use_bar = 0;
        hipLaunchKernelGGL(enc_fwd, dim3(grid), dim3(512), LDS_BYTES, stream, p); }
#endif
}
```
